# Optimizing an MI355X kernel written in HIP

```python
import math
import jax, jax.numpy as jnp
from jax import lax
import numpy as np

D_MODEL = 2048
BATCH = 1
SEQ = 16384
DEPTH = 4

D_MIX = D_MODEL
MLA_HEADS = 8
QK_NOPE_DIM = 128
QK_ROPE_DIM = 64
V_HEAD_DIM = 128
Q_LORA_RANK = 512
KV_LORA_RANK = 256
D_MLA = MLA_HEADS * V_HEAD_DIM
D_SSM = D_MIX - D_MLA
SSM_GROUP_CH = 16
SSM_GROUPS = D_SSM // SSM_GROUP_CH
SSM_STATE = 64
ROPE_THETA = 10000.0
NORM_EPS = 1e-6
Q_BLOCK = 128
STEP_MIN = 1e-3
STEP_MAX = 1e-1
D_IN = Q_LORA_RANK + KV_LORA_RANK + QK_ROPE_DIM + D_MLA + D_SSM + D_SSM

kernel_name = 'hymba_mla_s5_sandwich'


def _rms_norm(x, g):
    xf = x.astype(jnp.float32)
    inv = lax.rsqrt(jnp.mean(xf * xf, axis=-1, keepdims=True) + NORM_EPS)
    return (xf * inv * g.astype(jnp.float32)).astype(x.dtype)


def _rope_tables(positions):
    inv_freq = ROPE_THETA ** (-jnp.arange(0, QK_ROPE_DIM, 2, dtype=jnp.float32) / QK_ROPE_DIM)
    ang = positions.astype(jnp.float32)[..., None] * inv_freq
    ang = jnp.concatenate([ang, ang], axis=-1)
    return jnp.cos(ang), jnp.sin(ang)


def _apply_rope(x, cos, sin):
    xf = x.astype(jnp.float32)
    x1, x2 = jnp.split(xf, 2, axis=-1)
    rot = jnp.concatenate([-x2, x1], axis=-1)
    return (xf * cos + rot * sin).astype(x.dtype)


def _mla(c_q, c_kv, k_rope, positions, g_q, w_uq, g_kv, w_ukv):
    b, l, _ = c_q.shape
    q = jnp.einsum('blr,rf->blf', _rms_norm(c_q, g_q), w_uq)
    q = q.reshape(b, l, MLA_HEADS, QK_NOPE_DIM + QK_ROPE_DIM)
    q_nope, q_rope = q[..., :QK_NOPE_DIM], q[..., QK_NOPE_DIM:]
    kv = jnp.einsum('blr,rf->blf', _rms_norm(c_kv, g_kv), w_ukv)
    kv = kv.reshape(b, l, MLA_HEADS, QK_NOPE_DIM + V_HEAD_DIM)
    k_nope, v = kv[..., :QK_NOPE_DIM], kv[..., QK_NOPE_DIM:]
    cos, sin = _rope_tables(positions)
    q_rope = _apply_rope(q_rope, cos[:, :, None, :], sin[:, :, None, :])
    k_rope = _apply_rope(k_rope, cos, sin)

    n_blk = l // Q_BLOCK
    qn_blk = q_nope.reshape(b, n_blk, Q_BLOCK, MLA_HEADS, QK_NOPE_DIM).transpose(1, 0, 2, 3, 4)
    qr_blk = q_rope.reshape(b, n_blk, Q_BLOCK, MLA_HEADS, QK_ROPE_DIM).transpose(1, 0, 2, 3, 4)
    key_idx = jnp.arange(l)
    scale = 1.0 / math.sqrt(QK_NOPE_DIM + QK_ROPE_DIM)
    neg = jnp.finfo(jnp.float32).min

    def block(args):
        qn, qr, i = args
        s = (jnp.einsum('bqhd,bkhd->bhqk', qn, k_nope)
             + jnp.einsum('bqhr,bkr->bhqk', qr, k_rope))
        s = s.astype(jnp.float32) * scale
        q_idx = i * Q_BLOCK + jnp.arange(Q_BLOCK)
        causal = key_idx[None, :] <= q_idx[:, None]
        s = jnp.where(causal[None, None], s, neg)
        p = jax.nn.softmax(s, axis=-1).astype(v.dtype)
        return jnp.einsum('bhqk,bkhd->bqhd', p, v)

    o = lax.map(block, (qn_blk, qr_blk, jnp.arange(n_blk)))
    return o.transpose(1, 0, 2, 3, 4).reshape(b, l, D_MLA)


def _ssm_combine(e1, e2):
    a1, b1 = e1
    a2, b2 = e2
    return a1 * a2, a2 * b1 + b2


def _s5(u, a_re, a_im, b_re, b_im, c_re, c_im, d_skip, log_step, w_glu):
    b, l, _ = u.shape
    uf = u.astype(jnp.float32).reshape(b, l, SSM_GROUPS, SSM_GROUP_CH)
    a = lax.complex(a_re.astype(jnp.float32), a_im.astype(jnp.float32))
    step = jnp.exp(log_step.astype(jnp.float32))[:, None]
    a_bar = jnp.exp(step * a)
    b_mat = lax.complex(b_re.astype(jnp.float32), b_im.astype(jnp.float32))
    b_bar = ((a_bar - 1.0) / a)[..., None] * b_mat
    bu = jnp.einsum('gph,blgh->blgp', b_bar, uf.astype(jnp.complex64))
    a_seq = jnp.broadcast_to(a_bar, bu.shape)
    _, states = lax.associative_scan(_ssm_combine, (a_seq, bu), axis=1)
    c_mat = lax.complex(c_re.astype(jnp.float32), c_im.astype(jnp.float32))
    y = (jnp.einsum('ghp,blgp->blgh', c_mat, states).real
         + d_skip.astype(jnp.float32).reshape(SSM_GROUPS, SSM_GROUP_CH) * uf)
    y = jax.nn.gelu(y.reshape(b, l, D_SSM)).astype(u.dtype)
    val, gate = jnp.split(jnp.einsum('blc,cf->blf', y, w_glu), 2, axis=-1)
    return val * jax.nn.sigmoid(gate)


def _layer(x, positions, g_pre, g_post, w_in, g_q, w_uq, g_kv, w_ukv,
           a_re, a_im, b_re, b_im, c_re, c_im, d_skip, log_step, w_glu, w_out):
    h = _rms_norm(x, g_pre)
    proj = jnp.einsum('bld,df->blf', h, w_in)
    s1 = Q_LORA_RANK
    s2 = s1 + KV_LORA_RANK
    s3 = s2 + QK_ROPE_DIM
    s4 = s3 + D_MLA
    s5 = s4 + D_SSM
    c_q, c_kv, k_rope, gate_mla, u_ssm, gate_ssm = jnp.split(proj, [s1, s2, s3, s4, s5], axis=-1)
    mla_out = _mla(c_q, c_kv, k_rope, positions, g_q, w_uq, g_kv, w_ukv)
    ssm_out = _s5(u_ssm, a_re, a_im, b_re, b_im, c_re, c_im, d_skip, log_step, w_glu)
    mixed = jnp.concatenate([mla_out * jax.nn.silu(gate_mla),
                             ssm_out * jax.nn.silu(gate_ssm)], axis=-1)
    out = jnp.einsum('blf,fd->bld', mixed, w_out)
    return x + _rms_norm(out, g_post)


def setup_inputs(seed: int = 0) -> dict:
    key = jax.random.key(seed)
    k = jax.random.split(key, 20)
    f32 = jnp.float32
    x = jax.random.normal(k[0], (BATCH, SEQ, D_MODEL), f32)
    offset = jax.random.randint(k[1], (BATCH, 1), 0, 4096, dtype=jnp.int32)
    positions = (jnp.arange(SEQ, dtype=jnp.int32)[None, :] + offset).astype(jnp.int32)
    norm_pre = 1.0 + 0.1 * jax.random.normal(k[2], (DEPTH, D_MODEL), f32)
    norm_post = 1.0 + 0.1 * jax.random.normal(k[3], (DEPTH, D_MODEL), f32)
    w_in = jax.random.normal(k[4], (DEPTH, D_MODEL, D_IN), f32) * D_MODEL ** -0.5
    q_norm = 1.0 + 0.1 * jax.random.normal(k[5], (DEPTH, Q_LORA_RANK), f32)
    w_uq = jax.random.normal(k[6], (DEPTH, Q_LORA_RANK, MLA_HEADS * (QK_NOPE_DIM + QK_ROPE_DIM)), f32) * Q_LORA_RANK ** -0.5
    kv_norm = 1.0 + 0.1 * jax.random.normal(k[7], (DEPTH, KV_LORA_RANK), f32)
    w_ukv = jax.random.normal(k[8], (DEPTH, KV_LORA_RANK, MLA_HEADS * (QK_NOPE_DIM + V_HEAD_DIM)), f32) * KV_LORA_RANK ** -0.5
    ssm_a_re = -0.5 * jnp.exp(0.05 * jax.random.normal(k[9], (DEPTH, SSM_GROUPS, SSM_STATE), f32))
    ssm_a_im = (math.pi * jnp.arange(SSM_STATE, dtype=f32)[None, None, :]
                + 0.01 * jax.random.normal(k[10], (DEPTH, SSM_GROUPS, SSM_STATE), f32))
    b_scale = (SSM_GROUP_CH ** -0.5) / math.sqrt(2.0)
    c_scale = (SSM_STATE ** -0.5) / math.sqrt(2.0)
    ssm_b_re = jax.random.normal(k[11], (DEPTH, SSM_GROUPS, SSM_STATE, SSM_GROUP_CH), f32) * b_scale
    ssm_b_im = jax.random.normal(k[12], (DEPTH, SSM_GROUPS, SSM_STATE, SSM_GROUP_CH), f32) * b_scale
    ssm_c_re = jax.random.normal(k[13], (DEPTH, SSM_GROUPS, SSM_GROUP_CH, SSM_STATE), f32) * c_scale
    ssm_c_im = jax.random.normal(k[14], (DEPTH, SSM_GROUPS, SSM_GROUP_CH, SSM_STATE), f32) * c_scale
    ssm_d = jax.random.normal(k[15], (DEPTH, D_SSM), f32)
    ssm_log_step = jax.random.uniform(k[16], (DEPTH, SSM_GROUPS), f32,
                                      minval=math.log(STEP_MIN), maxval=math.log(STEP_MAX))
    w_glu = jax.random.normal(k[17], (DEPTH, D_SSM, 2 * D_SSM), f32) * D_SSM ** -0.5
    w_out = jax.random.normal(k[18], (DEPTH, D_MIX, D_MODEL), f32) * D_MIX ** -0.5
    return {'x': x, 'positions': positions, 'norm_pre': norm_pre, 'norm_post': norm_post,
            'w_in': w_in, 'q_norm': q_norm, 'w_uq': w_uq, 'kv_norm': kv_norm, 'w_ukv': w_ukv,
            'ssm_a_re': ssm_a_re, 'ssm_a_im': ssm_a_im, 'ssm_b_re': ssm_b_re, 'ssm_b_im': ssm_b_im,
            'ssm_c_re': ssm_c_re, 'ssm_c_im': ssm_c_im, 'ssm_d': ssm_d, 'ssm_log_step': ssm_log_step,
            'w_glu': w_glu, 'w_out': w_out}


def reference(x, positions, norm_pre, norm_post, w_in, q_norm, w_uq, kv_norm, w_ukv,
              ssm_a_re, ssm_a_im, ssm_b_re, ssm_b_im, ssm_c_re, ssm_c_im, ssm_d,
              ssm_log_step, w_glu, w_out):
    h = x
    for i in range(DEPTH):
        h = _layer(h, positions, norm_pre[i], norm_post[i], w_in[i], q_norm[i], w_uq[i],
                   kv_norm[i], w_ukv[i], ssm_a_re[i], ssm_a_im[i], ssm_b_re[i], ssm_b_im[i],
                   ssm_c_re[i], ssm_c_im[i], ssm_d[i], ssm_log_step[i], w_glu[i], w_out[i])
    return h
```

```cpp
#include <hip/hip_runtime.h>
#include <hip/hip_cooperative_groups.h>
#include <cstdio>
#include <cstring>
#include <cmath>
namespace cg = cooperative_groups;

#define LAS __attribute__((address_space(3)))
typedef unsigned short bf16_t;
typedef short bf16x8 __attribute__((ext_vector_type(8)));
typedef float f32x4 __attribute__((ext_vector_type(4)));
typedef float f32x2 __attribute__((ext_vector_type(2)));
typedef float f32x16 __attribute__((ext_vector_type(16)));
typedef unsigned u32x4 __attribute__((ext_vector_type(4)));
typedef unsigned u32x2 __attribute__((ext_vector_type(2)));

constexpr int SEQ = 16384, DM = 2048, NIN = 4096  , NIN_REAL = 3904, DEPTH = 4;
constexpr int C_CQ = 0, C_CKV = 512, C_KR = 768, C_GM = 832, C_U = 1856, C_GS = 2880;
constexpr int NQ = 1536, NKF = 1536;
constexpr int TCH = 16, NCH = SEQ / TCH  , KCAT = 384;
constexpr float EPS = 1e-6f;

constexpr size_t OFF_XN = 0;
constexpr size_t OFF_MIXED = 0;
constexpr size_t OFF_PROJ = OFF_XN + (size_t)SEQ * DM * 2;
constexpr size_t OFF_UCAT = OFF_PROJ + (size_t)SEQ * NIN * 2;
constexpr size_t OFF_Q = OFF_UCAT + (size_t)64 * NCH * KCAT * 2;
constexpr size_t OFF_YACT = OFF_Q;
constexpr size_t OFF_KF = OFF_Q + (size_t)SEQ * NQ * 2;
constexpr size_t OFF_VT = OFF_KF + (size_t)SEQ * NKF * 2;
constexpr size_t OFF_OUTB = OFF_KF;
constexpr size_t OFF_EBUF = OFF_XN;
constexpr size_t OFF_WIN = OFF_VT + (size_t)1024 * SEQ * 2;
constexpr size_t OFF_WUQ = OFF_WIN + (size_t)NIN * DM * 2;
constexpr size_t OFF_WK = OFF_WUQ + (size_t)1536 * 512 * 2;
constexpr size_t OFF_WV = OFF_WK + (size_t)1024 * 256 * 2;
constexpr size_t OFF_WGLU = OFF_WV + (size_t)1024 * 256 * 2;
constexpr size_t OFF_WOUT = OFF_WGLU + (size_t)2048 * 1024 * 2;
constexpr size_t OFF_BT1 = OFF_WOUT + (size_t)2048 * 2048 * 2;
constexpr size_t BT1_BYTES = (size_t)(64 * 128 + 128) * 256 * 2, BT2_BYTES = (size_t)64 * 256 * KCAT * 2;
constexpr size_t OFF_BT2 = OFF_BT1 + DEPTH * BT1_BYTES;
constexpr size_t OFF_COS = OFF_BT2 + DEPTH * BT2_BYTES;
constexpr size_t OFF_SIN = OFF_COS + (size_t)SEQ * 32 * 4;
constexpr size_t OFF_SS = OFF_SIN + (size_t)SEQ * 32 * 4;
constexpr size_t OFF_BAR = OFF_SS + (size_t)SEQ * 16 * 4;
constexpr size_t BAR_BYTES = 3456 * 4;
constexpr size_t WS_NEED = OFF_BAR + BAR_BYTES;

struct Params {
    const float* x; const int* pos; const float* norm_pre; const float* norm_post; const float* w_in; const float* q_norm; const float* w_uq;
    const float* kv_norm; const float* w_ukv; const float* a_re; const float* a_im; const float* b_re; const float* b_im; const float* c_re;
    const float* c_im; const float* d_skip; const float* log_step; const float* w_glu; const float* w_out;
    float* out; unsigned char* ws; unsigned long long pad0;
    float inv_freq[32];
    int ph_begin, ph_end, coop, pad1;
};

__device__ __forceinline__ unsigned cvt_pk_bf16(float lo, float hi) { unsigned r; asm volatile("v_cvt_pk_bf16_f32 %0, %1, %2" : "=v"(r) : "v"(lo), "v"(hi)); return r; }
__device__ __forceinline__ float bf2f(unsigned short b) { return __uint_as_float(((unsigned)b) << 16); }
__device__ __forceinline__ float bflo(unsigned w) { return __uint_as_float(w << 16); }
__device__ __forceinline__ float bfhi(unsigned w) { return __uint_as_float(w & 0xffff0000u); }
__device__ __forceinline__ u32x4 pack8(f32x4 a, f32x4 b) { u32x4 r; r[0] = cvt_pk_bf16(a[0], a[1]); r[1] = cvt_pk_bf16(a[2], a[3]); r[2] = cvt_pk_bf16(b[0], b[1]); r[3] = cvt_pk_bf16(b[2], b[3]); return r; }
__device__ __forceinline__ size_t erow_off(int R) { return (size_t)(R >> 2) * 1024 + 512 + (size_t)(R & 3) * 128; }
__device__ __forceinline__ float fast_exp2(float x) { return __builtin_amdgcn_exp2f(x); }
__device__ __forceinline__ float fast_rcp(float x) { return __builtin_amdgcn_rcpf(x); }
__device__ __forceinline__ float sigmoidf_(float x) { return fast_rcp(1.0f + fast_exp2(-1.4426950408889634f * x)); }
__device__ __forceinline__ float siluf_(float x) { return x * sigmoidf_(x); }
__device__ __forceinline__ float gelu_tanh(float x) {
    const float u = 0.7978845608028654f * (x + 0.044715f * x * x * x);
    return x * sigmoidf_(2.0f * u);
}
__device__ __forceinline__ void sincos_rev_d(double ang, float& s, float& c) {
    double rev = ang * 0.15915494309189533577; rev -= rint(rev);
    const float f = (float)rev; s = __builtin_amdgcn_sinf(f); c = __builtin_amdgcn_cosf(f);
}
__device__ __forceinline__ void sincos_rev(float ang, float& s, float& c) {
    double rev = (double)ang * 0.15915494309189533577; rev -= rint(rev);
    const float f = (float)rev; s = __builtin_amdgcn_sinf(f); c = __builtin_amdgcn_cosf(f);
}

__device__ __forceinline__ int launder_v(int x) { asm volatile("" : "+v"(x)); return x; }
__device__ __forceinline__ int launder_s(int x) { asm volatile("" : "+s"(x)); return x; }
__device__ __forceinline__ int lane_id_asm() { int x; asm volatile("v_mbcnt_lo_u32_b32 %0, -1, 0\n\tv_mbcnt_hi_u32_b32 %0, -1, %0" : "=&v"(x)); return x; }
#define TID() (launder_s(wv) * 64 + lane_id_asm())
#define BID() launder_s((int)blockIdx.x)
#define GDIM() launder_s((int)gridDim.x)
#define LIDS const int tid_l = TID(), bid_l = BID(), gdim_l = GDIM(); (void)tid_l; (void)bid_l; (void)gdim_l;
constexpr int BM = 256, BK = 64, HALF = 128, HTB = HALF * BK * 2, STAGE_BYTES = 8 * HTB, NXCD = 8, WGM = 8;
__device__ __forceinline__ int lds_byte(int r, int c) { const int st = (r >> 4) * 2 + (c >> 5), rr = r & 15, cc = c & 31, ob = rr * 64 + cc * 2; return st * 1024 + (ob ^ (((ob >> 9) & 1) << 5)); }
__device__ __forceinline__ void stage_rc(int b, int& R, int& C) { const int st = b / 1024, sb = b % 1024, swz = sb ^ (((sb >> 9) & 1) << 5); R = (st >> 1) * 16 + swz / 64; C = (st & 1) * 32 + (swz % 64) / 2; }
__device__ __forceinline__ int perm32(int rho) { const int n = rho >> 4, i = rho & 15; return 8 * (i >> 2) + 4 * n + (i & 3); }

struct Unit { int pm, pn; };
struct Gemm { const bf16_t* A; const bf16_t* Bt; int lda, ldb, K; size_t tstepA, tstepB; int amode; };

struct StaticOrder {
    int nM, nN, nwg, G, c;
    __device__ void init(int M, int N, int G_, int c_) { nM = M / BM; nN = N / BM; nwg = nM * nN; G = G_; c = c_; }
    __device__ bool next(int i, Unit& u) const {
        const long L = (long)i * G + c; if (L >= nwg) return false;
        int wgid = (int)L; { const int q = nwg / NXCD, r = nwg % NXCD, xcd = wgid % NXCD, off = wgid / NXCD; wgid = (xcd < r ? xcd * (q + 1) : r * (q + 1) + (xcd - r) * q) + off; }
        const int nig = WGM * nN, gid = wgid / nig, fm = gid * WGM, gsz = (nM - fm) < WGM ? (nM - fm) : WGM;
        u.pm = fm + ((wgid % nig) % gsz); u.pn = (wgid % nig) / gsz; return true;
    }
};
struct GroupOrderE {
    int G, c;
    __device__ bool next(int i, Unit& u) const { int idx; if (G == 256) { if (c < 128 || i >= 2) return false; const int xcd = c & 7, k2 = ((c - 128) >> 3) * 2 + i; idx = (xcd * 8 + (k2 >> 2)) * 4 + (k2 & 3); } else { idx = i * G + ((c + G / 2) % G); if (idx >= 256) return false; }
        u.pm = idx; u.pn = idx >> 2; return true; }
};
struct GroupOrder {
    int G, c;
    __device__ bool next(int i, Unit& u) const { int idx = i * G + c; if (idx >= 256) return false;
        if (G == 256) { const int xcd = c & 7, k = c >> 3; idx = (xcd * 8 + (k >> 2)) * 4 + (k & 3); }
        u.pm = idx; u.pn = idx >> 2; return true; }
};

template <class Epi, class Sched>
__device__ __forceinline__ void gemm_phase(int wv, LAS unsigned char* lds, const Gemm g, const Sched& S, const Epi& E) { LIDS
    const int tid = tid_l, wid = __builtin_amdgcn_readfirstlane(tid >> 6), lane = tid & 63, wr = wid >> 2, wc = wid & 3, fr = lane & 15, fq = lane >> 4;
    const int K = g.K, nt = K / BK;
    unsigned voffA, voffB;
    { int R, C; stage_rc(tid * 16, R, C); const int Rb = (R & ~31) + perm32(R & 31);
      voffA = g.amode ? (unsigned)((C >> 4) * (SEQ * 16) + R * 16 + (C & 15)) * 2u : (unsigned)(R * g.lda + C) * 2u; voffB = (unsigned)(Rb * g.ldb + C) * 2u; }
    const size_t rowA = g.amode ? (size_t)32 : (size_t)g.lda * 2;
    const size_t voffA_q = 64 * rowA, voffB_q = (size_t)64 * g.ldb * 2;
    const size_t kstepA = g.amode ? (size_t)4 * SEQ * 32 : (size_t)(BK * 2), kstepB = (size_t)(BK * 2);
    const size_t hstepA = HALF * rowA, hstepB = (size_t)HALF * g.ldb * 2;
    const unsigned ldsw = (unsigned)wid * 1024u;
    const int aoff = lds_byte(wr * 64 + fr, fq * 8), boff = lds_byte(wc * 32 + fr, fq * 8);
#define PG8_SA(b, h) (((b) * 2 + (h)) * HTB)
#define PG8_SB(b, h) ((4 + (b) * 2 + (h)) * HTB)
#define PG8_STAGE(bufoff, gbase, voff) do { _Pragma("unroll") for (int _i = 0; _i < 2; ++_i) { const char* _gb = (const char*)(gbase) + (size_t)_i * (voff##_q); asm volatile("" : "+s"(_gb)); \
        __builtin_amdgcn_global_load_lds((const unsigned*)(_gb + (voff)), (LAS unsigned*)(lds + (bufoff) + ldsw + _i * 8192), 16, 0, 0); } } while (0)
#define PG8_LDA(dst, b, h) do { _Pragma("unroll") for (int m = 0; m < 4; ++m) _Pragma("unroll") for (int k = 0; k < 2; ++k) dst[m][k] = *(const LAS bf16x8*)(lds + PG8_SA(b, h) + aoff + m * 2048 + k * 1024); } while (0)
#define PG8_LDB(dst, b, h) do { _Pragma("unroll") for (int n = 0; n < 2; ++n) _Pragma("unroll") for (int k = 0; k < 2; ++k) dst[n][k] = *(const LAS bf16x8*)(lds + PG8_SB(b, h) + boff + n * 2048 + k * 1024); } while (0)
#define PG8_MMA(ai, bj, At, Bt) do { __builtin_amdgcn_s_setprio(1); _Pragma("unroll") for (int m = 0; m < 4; ++m) _Pragma("unroll") for (int n = 0; n < 2; ++n) _Pragma("unroll") for (int k = 0; k < 2; ++k) \
        acc[ai][bj][m][n] = __builtin_amdgcn_mfma_f32_16x16x32_bf16(Bt[n][k], At[m][k], acc[ai][bj][m][n], 0, 0, 0); __builtin_amdgcn_s_setprio(0); } while (0)
#define PG8_WAIT_V(n) asm volatile("s_waitcnt vmcnt(" #n ")" ::: "memory")
#define PG8_WAIT_L(n) asm volatile("s_waitcnt lgkmcnt(" #n ")" ::: "memory")
#define PG8_BAR __builtin_amdgcn_s_barrier()
#define PG8_SCHED __builtin_amdgcn_sched_barrier(0)
    Unit cur, nxt; int ui = 0;
    if (!S.next(0, cur)) return;
    float zf = 0.f; asm volatile("" : "+v"(zf)); const f32x4 zero4 = (f32x4){zf, zf, zf, zf};
    f32x4 acc[2][2][4][2];
#pragma unroll
    for (int a = 0; a < 2; ++a)
#pragma unroll
        for (int b = 0; b < 2; ++b)
#pragma unroll
            for (int m = 0; m < 4; ++m)
#pragma unroll
                for (int n = 0; n < 2; ++n) acc[a][b][m][n] = zero4;
    bf16x8 At[4][2], B0[2][2], B1[2][2];
    const char* cA = (const char*)g.A + (size_t)cur.pm * g.tstepA; const char* cB = (const char*)g.Bt + (size_t)cur.pn * g.tstepB;
    PG8_STAGE(PG8_SB(0, 0), cB, voffB); PG8_STAGE(PG8_SA(0, 0), cA, voffA); PG8_STAGE(PG8_SB(0, 1), cB + hstepB, voffB); PG8_STAGE(PG8_SA(0, 1), cA + hstepA, voffA);
    if (wr == 1) PG8_BAR;
    PG8_WAIT_V(4); PG8_BAR;
    PG8_STAGE(PG8_SB(1, 0), cB + kstepB, voffB); PG8_STAGE(PG8_SA(1, 0), cA + kstepA, voffA); PG8_STAGE(PG8_SB(1, 1), cB + hstepB + kstepB, voffB);
    PG8_WAIT_V(6); PG8_BAR;
    for (;;) {
        const bool has_next = S.next(ui + 1, nxt);
        const char* nA = has_next ? (const char*)g.A + (size_t)nxt.pm * g.tstepA : cA; const char* nB = has_next ? (const char*)g.Bt + (size_t)nxt.pn * g.tstepB : cB;
        for (int t = 0; t < nt; t += 2) {
            const bool last = (t == nt - 2);
            const char* a1 = cA + (size_t)(t + 1) * kstepA;
            const char* a2 = last ? nA : cA + (size_t)(t + 2) * kstepA; const char* b2 = last ? nB : cB + (size_t)(t + 2) * kstepB;
            const char* a3 = a2 + kstepA; const char* b3 = b2 + kstepB;
            asm volatile("" : "+s"(a1), "+s"(a2), "+s"(b2), "+s"(a3), "+s"(b3));
            PG8_LDB(B0, 0, 0); PG8_SCHED; PG8_LDA(At, 0, 0); PG8_STAGE(PG8_SA(1, 1), a1 + hstepA, voffA);
            PG8_WAIT_L(8); PG8_BAR; PG8_WAIT_L(0); PG8_MMA(0, 0, At, B0); PG8_BAR; PG8_SCHED;
            PG8_LDB(B1, 0, 1); PG8_STAGE(PG8_SB(0, 0), b2, voffB);
            PG8_BAR; PG8_WAIT_L(0); PG8_MMA(0, 1, At, B1); PG8_BAR;
            PG8_LDA(At, 0, 1); PG8_STAGE(PG8_SA(0, 0), a2, voffA);
            PG8_BAR; PG8_WAIT_L(0); PG8_MMA(1, 0, At, B0); PG8_BAR; PG8_SCHED;
            PG8_STAGE(PG8_SB(0, 1), b2 + hstepB, voffB);
            PG8_WAIT_V(6); PG8_BAR; PG8_MMA(1, 1, At, B1); PG8_BAR;
            PG8_LDB(B0, 1, 0); PG8_SCHED; PG8_LDA(At, 1, 0); PG8_STAGE(PG8_SA(0, 1), a2 + hstepA, voffA);
            PG8_WAIT_L(8); PG8_BAR; PG8_WAIT_L(0); PG8_MMA(0, 0, At, B0); PG8_BAR; PG8_SCHED;
            PG8_LDB(B1, 1, 1); PG8_STAGE(PG8_SB(1, 0), b3, voffB);
            PG8_BAR; PG8_WAIT_L(0); PG8_MMA(0, 1, At, B1); PG8_BAR;
            PG8_LDA(At, 1, 1); PG8_STAGE(PG8_SA(1, 0), a3, voffA);
            PG8_BAR; PG8_WAIT_L(0); PG8_MMA(1, 0, At, B0); PG8_BAR; PG8_SCHED;
            PG8_STAGE(PG8_SB(1, 1), b3 + hstepB, voffB);
            PG8_WAIT_V(6); PG8_BAR; PG8_MMA(1, 1, At, B1); PG8_BAR;
        }
        { const int l2 = lane_id_asm(); E(acc, cur, wr, wc, l2 & 15, l2 >> 4); }
        if (!has_next) break;
#pragma unroll
        for (int a = 0; a < 2; ++a)
#pragma unroll
            for (int b = 0; b < 2; ++b)
#pragma unroll
                for (int m = 0; m < 4; ++m)
#pragma unroll
                    for (int n = 0; n < 2; ++n) acc[a][b][m][n] = zero4;
        cur = nxt; cA = nA; cB = nB; ++ui;
    }
    PG8_WAIT_V(0);
    if (wr == 0) PG8_BAR;
    PG8_BAR;
#undef PG8_SA
#undef PG8_SB
#undef PG8_STAGE
#undef PG8_LDA
#undef PG8_LDB
#undef PG8_MMA
#undef PG8_WAIT_V
#undef PG8_WAIT_L
#undef PG8_BAR
#undef PG8_SCHED
}

typedef f32x4 AccT[2][2][4][2];
#define EPI_ROWS(u) const int row0 = (u).pm * BM + wr * 64 + fr; const int colbase = (u).pn * BM + wc * 32 + 8 * fq;

struct EpiProj {
    bf16_t* proj; bf16_t* ucat; float* ssp;
    __device__ __forceinline__ void operator()(const AccT& acc, const Unit& u, int wr, int wc, int fr, int fq) const {
        EPI_ROWS(u)
        const bool do_ss = (u.pn <= 2);
#pragma unroll
        for (int ai = 0; ai < 2; ++ai)
#pragma unroll
            for (int m = 0; m < 4; ++m) {
                const int row = row0 + ai * HALF + m * 16; float ss = 0.f;
#pragma unroll
                for (int bj = 0; bj < 2; ++bj) {
                    const int col = colbase + bj * HALF; const f32x4 v0 = acc[ai][bj][m][0], v1 = acc[ai][bj][m][1];
                    const u32x4 pk = pack8(v0, v1);
                    if (col >= C_U && col < C_GS) { const int ch = col - C_U, gg = ch >> 4, hh = ch & 15;
                        *(u32x4*)(ucat + ((size_t)(gg * NCH + (row >> 4)) * KCAT + (row & 15) * 16 + hh)) = pk; }
                    else if (col < NIN_REAL) *(u32x4*)(proj + (size_t)row * NIN + col) = pk;
                    if (do_ss) ss += v0[0] * v0[0] + v0[1] * v0[1] + v0[2] * v0[2] + v0[3] * v0[3] + v1[0] * v1[0] + v1[1] * v1[1] + v1[2] * v1[2] + v1[3] * v1[3];
                }
                __builtin_amdgcn_sched_barrier(0);
                if (do_ss) { ss += __shfl_xor(ss, 16); ss += __shfl_xor(ss, 32); if (fq == 0) ssp[(size_t)row * 16 + u.pn * 4 + wc] = ss; }
            }
    }
};
struct EpiQ {
    bf16_t* Q; const float* ssp; const float* cosT; const float* sinT;
    __device__ __forceinline__ void operator()(const AccT& acc, const Unit& u, int wr, int wc, int fr, int fq) const {
        EPI_ROWS(u)
#pragma unroll
        for (int ai = 0; ai < 2; ++ai)
#pragma unroll
            for (int m = 0; m < 4; ++m) {
                const int row = row0 + ai * HALF + m * 16;
                const f32x4 pa = *(const f32x4*)(ssp + (size_t)row * 16), pb = *(const f32x4*)(ssp + (size_t)row * 16 + 4);
                const float ssr = ((pa[0] + pa[1]) + (pa[2] + pa[3])) + ((pb[0] + pb[1]) + (pb[2] + pb[3]));
                const float sc = rsqrtf(ssr * (1.0f / 512.0f) + EPS) * (1.4426950408889634f * 0.07216878364870322f);
#pragma unroll
                for (int bj = 0; bj < 2; ++bj) {
                    const int col = colbase + bj * HALF; f32x4 v0 = acc[ai][bj][m][0], v1 = acc[ai][bj][m][1];
                    const int d = col % 192;
                    if (d >= 128) { const int i0 = (d - 128) >> 1;
                        const f32x4 c4 = *(const f32x4*)(cosT + (size_t)row * 32 + i0), s4 = *(const f32x4*)(sinT + (size_t)row * 32 + i0);
                        f32x4 o0, o1;
                        o0[0] = v0[0] * c4[0] - v0[1] * s4[0]; o0[1] = v0[1] * c4[0] + v0[0] * s4[0];
                        o0[2] = v0[2] * c4[1] - v0[3] * s4[1]; o0[3] = v0[3] * c4[1] + v0[2] * s4[1];
                        o1[0] = v1[0] * c4[2] - v1[1] * s4[2]; o1[1] = v1[1] * c4[2] + v1[0] * s4[2];
                        o1[2] = v1[2] * c4[3] - v1[3] * s4[3]; o1[3] = v1[3] * c4[3] + v1[2] * s4[3];
                        v0 = o0; v1 = o1; }
                    *(u32x4*)(Q + (size_t)row * NQ + col) = pack8(v0 * sc, v1 * sc); __builtin_amdgcn_sched_barrier(0);
                }
            }
    }
};
struct EpiK {
    bf16_t* Kf; const float* ssp;
    __device__ __forceinline__ void operator()(const AccT& acc, const Unit& u, int wr, int wc, int fr, int fq) const {
        EPI_ROWS(u)
#pragma unroll
        for (int ai = 0; ai < 2; ++ai)
#pragma unroll
            for (int m = 0; m < 4; ++m) {
                const int row = row0 + ai * HALF + m * 16;
                const f32x4 pc = *(const f32x4*)(ssp + (size_t)row * 16 + 8);
                const float sc = rsqrtf(((pc[0] + pc[1]) + (pc[2] + pc[3])) * (1.0f / 256.0f) + EPS);
#pragma unroll
                for (int bj = 0; bj < 2; ++bj) {
                    const int col = colbase + bj * HALF, head = col >> 7, d = col & 127;
                    *(u32x4*)(Kf + (size_t)row * NKF + head * 192 + d) = pack8(acc[ai][bj][m][0] * sc, acc[ai][bj][m][1] * sc);
                }
            }
    }
};
struct EpiVt {
    bf16_t* Vt; const float* ssp;
    __device__ __forceinline__ void operator()(const AccT& acc, const Unit& u, int wr, int wc, int fr, int fq) const {
        EPI_ROWS(u)
#pragma unroll
        for (int bj = 0; bj < 2; ++bj) {
            const int col = colbase + bj * HALF;
            f32x4 s0, s1;
#pragma unroll
            for (int j = 0; j < 4; ++j) { const f32x4 pc = *(const f32x4*)(ssp + (size_t)(col + j) * 16 + 8), pd = *(const f32x4*)(ssp + (size_t)(col + 4 + j) * 16 + 8);
                s0[j] = rsqrtf(((pc[0] + pc[1]) + (pc[2] + pc[3])) * (1.0f / 256.0f) + EPS); s1[j] = rsqrtf(((pd[0] + pd[1]) + (pd[2] + pd[3])) * (1.0f / 256.0f) + EPS); }
#pragma unroll
            for (int ai = 0; ai < 2; ++ai)
#pragma unroll
                for (int m = 0; m < 4; ++m) {
                    const int row = row0 + ai * HALF + m * 16;
                    *(u32x4*)(Vt + (size_t)row * SEQ + col) = pack8(acc[ai][bj][m][0] * s0, acc[ai][bj][m][1] * s1);
                }
        }
    }
};
struct EpiE {
    float* Ebuf;
    __device__ __forceinline__ void operator()(const AccT& acc, const Unit& u, int wr, int wc, int fr, int fq) const {
        const int row0 = u.pm * BM + wr * 64 + fr, cc = wc * 32 + 8 * fq;
#pragma unroll
        for (int ai = 0; ai < 2; ++ai)
#pragma unroll
            for (int m = 0; m < 4; ++m) {
                const int row = row0 + ai * HALF + m * 16;
                *(f32x4*)(Ebuf + erow_off(row) + cc) = acc[ai][0][m][0]; *(f32x4*)(Ebuf + erow_off(row) + cc + 4) = acc[ai][0][m][1];
            }
    }
};
struct EpiY {
    bf16_t* Yact; const bf16_t* ucat; const float* dskip;
    __device__ __forceinline__ void operator()(const AccT& acc, const Unit& u, int wr, int wc, int fr, int fq) const {
        const int row0 = u.pm * BM + wr * 64 + fr, g = u.pn;
#pragma unroll
        for (int bj = 0; bj < 2; ++bj) {
            const int n = bj * HALF + wc * 32 + 8 * fq, t = n >> 4, hh = n & 15;
            const f32x4 d0 = *(const f32x4*)(dskip + g * 16 + hh), d1 = *(const f32x4*)(dskip + g * 16 + hh + 4);
            u32x4 uv[8];
#pragma unroll
            for (int rr = 0; rr < 8; ++rr) uv[rr] = *(const u32x4*)(ucat + (size_t)(row0 + (rr >> 2) * HALF + (rr & 3) * 16) * KCAT + n);
            __builtin_amdgcn_sched_barrier(0);
#pragma unroll
            for (int ai = 0; ai < 2; ++ai)
#pragma unroll
                for (int m = 0; m < 4; ++m) {
                    const int R = row0 + ai * HALF + m * 16;
                    const u32x4 uu = uv[ai * 4 + m];
                    f32x4 y0 = acc[ai][bj][m][0], y1 = acc[ai][bj][m][1];
                    y0[0] += d0[0] * bflo(uu[0]); y0[1] += d0[1] * bfhi(uu[0]); y0[2] += d0[2] * bflo(uu[1]); y0[3] += d0[3] * bfhi(uu[1]);
                    y1[0] += d1[0] * bflo(uu[2]); y1[1] += d1[1] * bfhi(uu[2]); y1[2] += d1[2] * bflo(uu[3]); y1[3] += d1[3] * bfhi(uu[3]);
#pragma unroll
                    for (int j = 0; j < 4; ++j) { y0[j] = gelu_tanh(y0[j]); y1[j] = gelu_tanh(y1[j]); }
                    *(u32x4*)(Yact + (size_t)R * 256 + n) = pack8(y0, y1); __builtin_amdgcn_sched_barrier(0);
                }
        }
    }
};
struct EpiGlu {
    bf16_t* mixed; const bf16_t* proj;
    __device__ __forceinline__ void operator()(const AccT& acc, const Unit& u, int wr, int wc, int fr, int fq) const {
        const int row0 = u.pm * BM + wr * 64 + fr, ch = u.pn * 128 + wc * 32 + 8 * fq;
        u32x4 gsv[8];
#pragma unroll
        for (int rr = 0; rr < 8; ++rr) gsv[rr] = *(const u32x4*)(proj + (size_t)(row0 + (rr >> 2) * HALF + (rr & 3) * 16) * NIN + C_GS + ch);
        __builtin_amdgcn_sched_barrier(0);
#pragma unroll
        for (int ai = 0; ai < 2; ++ai)
#pragma unroll
            for (int m = 0; m < 4; ++m) {
                const int row = row0 + ai * HALF + m * 16;
                u32x4 wq;
#pragma unroll
                for (int n = 0; n < 2; ++n) {
                    const unsigned g_lo = gsv[ai * 4 + m][2 * n], g_hi = gsv[ai * 4 + m][2 * n + 1];
                    const f32x4 a0 = acc[ai][0][m][n], g0 = acc[ai][1][m][n];
                    const float o0 = a0[0] * sigmoidf_(g0[0]) * siluf_(bflo(g_lo)), o1 = a0[1] * sigmoidf_(g0[1]) * siluf_(bfhi(g_lo));
                    const float o2 = a0[2] * sigmoidf_(g0[2]) * siluf_(bflo(g_hi)), o3 = a0[3] * sigmoidf_(g0[3]) * siluf_(bfhi(g_hi));
                    wq[2 * n] = cvt_pk_bf16(o0, o1); wq[2 * n + 1] = cvt_pk_bf16(o2, o3);
                }
                *(u32x4*)(mixed + (size_t)row * DM + 1024 + ch) = wq;
                __builtin_amdgcn_sched_barrier(0);
            }
    }
};
struct EpiOut {
    bf16_t* outb;
    __device__ __forceinline__ void operator()(const AccT& acc, const Unit& u, int wr, int wc, int fr, int fq) const {
        EPI_ROWS(u)
#pragma unroll
        for (int ai = 0; ai < 2; ++ai)
#pragma unroll
            for (int m = 0; m < 4; ++m) {
                const int row = row0 + ai * HALF + m * 16;
#pragma unroll
                for (int bj = 0; bj < 2; ++bj) *(u32x4*)(outb + (size_t)row * DM + colbase + bj * HALF) = pack8(acc[ai][bj][m][0], acc[ai][bj][m][1]);
            }
    }
};

__device__ __forceinline__ float wave_sum(float v) {
#pragma unroll
    for (int o = 32; o >= 1; o >>= 1) v += __shfl_xor(v, o);
    return v;
}
__device__ __forceinline__ void rowpass(int wv, const float* xin, const bf16_t* outb, const float* g_post, const float* g_pre_next, float* xres, bf16_t* xn, int mode) { LIDS
    const int lane = tid_l & 63, wid = tid_l >> 6;
    for (int row = bid_l * 8 + wid; row < SEQ; row += gdim_l * 8) {
        f32x4 xv[8]; float ss = 0.f;
        if (mode == 0) {
#pragma unroll
            for (int i = 0; i < 8; ++i) xv[i] = __builtin_nontemporal_load((const f32x4*)(xin + (size_t)row * DM + i * 256 + lane * 4));
        } else {
            f32x4 ov[8]; float so = 0.f;
#pragma unroll
            for (int i = 0; i < 8; ++i) { const u32x2 w = __builtin_nontemporal_load((const u32x2*)(outb + (size_t)row * DM + i * 256 + lane * 4));
                ov[i][0] = bflo(w[0]); ov[i][1] = bfhi(w[0]); ov[i][2] = bflo(w[1]); ov[i][3] = bfhi(w[1]);
                so += ov[i][0] * ov[i][0] + ov[i][1] * ov[i][1] + ov[i][2] * ov[i][2] + ov[i][3] * ov[i][3]; }
            so = wave_sum(so); const float inv = rsqrtf(so * (1.0f / DM) + EPS);
#pragma unroll
            for (int i = 0; i < 8; ++i) { const f32x4 xo = __builtin_nontemporal_load((const f32x4*)(xin + (size_t)row * DM + i * 256 + lane * 4)); const f32x4 gp = *(const f32x4*)(g_post + i * 256 + lane * 4);
                xv[i] = xo + ov[i] * inv * gp; }
        }
#pragma unroll
        for (int i = 0; i < 8; ++i) { if (mode != 0) __builtin_nontemporal_store(xv[i], (f32x4*)(xres + (size_t)row * DM + i * 256 + lane * 4));
            ss += xv[i][0] * xv[i][0] + xv[i][1] * xv[i][1] + xv[i][2] * xv[i][2] + xv[i][3] * xv[i][3]; }
        if (g_pre_next) {
            ss = wave_sum(ss); const float inv = rsqrtf(ss * (1.0f / DM) + EPS);
#pragma unroll
            for (int i = 0; i < 8; ++i) { const f32x4 gp = *(const f32x4*)(g_pre_next + i * 256 + lane * 4); const f32x4 y = xv[i] * inv * gp;
                u32x2 w; w[0] = cvt_pk_bf16(y[0], y[1]); w[1] = cvt_pk_bf16(y[2], y[3]);
                *(u32x2*)(xn + (size_t)row * DM + i * 256 + lane * 4) = w; }
        }
    }
}

template <int MAP> __device__ __forceinline__ int wmap(int n) {
    if (MAP == 0) return n < NIN_REAL ? n : -1;
    if (MAP == 1) { const int head = n / 192, d = n % 192; if (d < 128) return n; const int e = d - 128; return head * 192 + 128 + (e & 1) * 32 + (e >> 1); }
    if (MAP == 2) return (n >> 7) * 256 + (n & 127);
    if (MAP == 3) return (n >> 7) * 256 + 128 + (n & 127);
    if (MAP == 4) { const int pn = n >> 8, r = n & 255; return r < 128 ? pn * 128 + r : 1024 + pn * 128 + (r - 128); }
    return n;
}
template <int MAP> __device__ __forceinline__ void transpose_tile(int wv, const float* src, int ldsrc, int K, const float* gain, bf16_t* dst, int tile, int ktiles, LAS float* tl) { LIDS
    const int n0 = (tile / ktiles) * 64, k0 = (tile % ktiles) * 256, tx = tid_l & 63, ty = tid_l >> 6;
    const int sc = wmap<MAP>(n0 + tx);
    float v[32];
#pragma unroll
    for (int i = 0; i < 32; ++i) { const int k = k0 + ty + 8 * i; v[i] = (sc >= 0) ? __builtin_nontemporal_load(src + (size_t)k * ldsrc + sc) : 0.f; }
    if (gain) {
#pragma unroll
        for (int i = 0; i < 32; ++i) v[i] *= gain[k0 + ty + 8 * i];
    }
#pragma unroll
    for (int i = 0; i < 32; ++i) tl[(ty + 8 * i) * 65 + tx] = v[i];
    __syncthreads();
    {
        const int r = tid_l >> 3;
#pragma unroll
        for (int q = 0; q < 4; ++q) { const int kq = (tid_l & 7) * 8 + 64 * q; f32x4 a, b;
#pragma unroll
            for (int jj = 0; jj < 4; ++jj) { a[jj] = tl[(kq + jj) * 65 + r]; b[jj] = tl[(kq + 4 + jj) * 65 + r]; }
            *(u32x4*)(dst + (size_t)(n0 + r) * K + k0 + kq) = pack8(a, b); }
    }
    __syncthreads();
}
__device__ __forceinline__ void prep_s5_group(int wv, const Params& p, int layer, int g, bf16_t* bt1, bf16_t* bt2, LAS float* L) { LIDS
    LAS float* apr = L; LAS float* api = apr + 17 * 64; LAS float* bbr = api + 17 * 64; LAS float* bbi = bbr + 1024; LAS float* cr = bbi + 1024; LAS float* ci = cr + 1024; LAS float* kt = ci + 1024;
    const int tid = tid_l; const size_t gp = (size_t)layer * 64 + g;
    const float step = expf(p.log_step[gp]);
    for (int i = tid; i < 17 * 64; i += 512) { const int d = i >> 6, pp = i & 63; const float are = p.a_re[gp * 64 + pp], aim = p.a_im[gp * 64 + pp];
        const float mag = expf((float)d * step * are); float s, c; sincos_rev_d((double)d * (double)step * (double)aim, s, c); apr[i] = mag * c; api[i] = mag * s; }
    for (int i = tid; i < 1024; i += 512) { const int hh = i >> 6, pp = i & 63; cr[i] = p.c_re[(gp * 16 + hh) * 64 + pp]; ci[i] = p.c_im[(gp * 16 + hh) * 64 + pp]; }
    __syncthreads();
    for (int i = tid; i < 1024; i += 512) { const int pp = i >> 4; const float are = p.a_re[gp * 64 + pp], aim = p.a_im[gp * 64 + pp];
        const float xr = apr[64 + pp] - 1.0f, xi = api[64 + pp], den = 1.0f / (are * are + aim * aim);
        const float qr = (xr * are + xi * aim) * den, qi = (xi * are - xr * aim) * den;
        const float br = p.b_re[gp * 1024 + i], bi = p.b_im[gp * 1024 + i];
        bbr[i] = qr * br - qi * bi; bbi[i] = qr * bi + qi * br; }
    __syncthreads();
    {
        const int i0 = tid * 8, d = i0 >> 8, hh = (i0 >> 4) & 15, h20 = i0 & 15; float acc8[8];
#pragma unroll
        for (int e = 0; e < 8; ++e) acc8[e] = 0.f;
        for (int pp = 0; pp < 64; ++pp) { const float wr_ = cr[hh * 64 + pp] * apr[d * 64 + pp] - ci[hh * 64 + pp] * api[d * 64 + pp], wi_ = cr[hh * 64 + pp] * api[d * 64 + pp] + ci[hh * 64 + pp] * apr[d * 64 + pp];
#pragma unroll
            for (int e = 0; e < 8; ++e) acc8[e] += wr_ * bbr[pp * 16 + h20 + e] - wi_ * bbi[pp * 16 + h20 + e]; }
#pragma unroll
        for (int e = 0; e < 8; ++e) kt[i0 + e] = acc8[e]; }
    __syncthreads();
    for (int i = tid; i < 256 * KCAT; i += 512) { const int n = i / KCAT, k = i % KCAT, t = n >> 4, hh = n & 15; float v;
        if (k < 256) { const int s = k >> 4, h2 = k & 15; v = (s <= t) ? kt[((t - s) * 16 + hh) * 16 + h2] : 0.f; }
        else { const int pp = (k - 256) >> 1, ri = k & 1, d = t + 1; const float fr_ = cr[hh * 64 + pp] * apr[d * 64 + pp] - ci[hh * 64 + pp] * api[d * 64 + pp], fi_ = cr[hh * 64 + pp] * api[d * 64 + pp] + ci[hh * 64 + pp] * apr[d * 64 + pp];
            v = ri ? -fi_ : fr_; }
        bt2[(size_t)g * 256 * KCAT + i] = (bf16_t)(cvt_pk_bf16(v, 0.f) & 0xffffu); }
    for (int i = tid; i < 128 * 256; i += 512) { const int n = i >> 8, k = i & 255, pp = n >> 1, ri = n & 1, t = k >> 4, hh = k & 15, d = 15 - t;
        const float er = apr[d * 64 + pp] * bbr[pp * 16 + hh] - api[d * 64 + pp] * bbi[pp * 16 + hh], ei = apr[d * 64 + pp] * bbi[pp * 16 + hh] + api[d * 64 + pp] * bbr[pp * 16 + hh];
        bt1[(size_t)g * 128 * 256 + i] = (bf16_t)(cvt_pk_bf16(ri ? ei : er, 0.f) & 0xffffu); }
    __syncthreads();
}
__device__ __forceinline__ void prep_layer(int wv, const Params& p, int layer, LAS unsigned char* lds) { LIDS
    unsigned char* ws = p.ws; LAS float* tl = (LAS float*)lds;
    const float* w_in = p.w_in + (size_t)layer * DM * NIN_REAL; const float* w_uq = p.w_uq + (size_t)layer * 512 * 1536; const float* w_ukv = p.w_ukv + (size_t)layer * 256 * 2048;
    const float* w_glu = p.w_glu + (size_t)layer * 1024 * 2048; const float* w_out = p.w_out + (size_t)layer * 2048 * 2048;
    const float* g_pre = nullptr;
    const float* g_q = p.q_norm + layer * 512; const float* g_kv = p.kv_norm + layer * 256;
    for (int t = bid_l; t < 976; t += gdim_l) {
        if (t < 512) transpose_tile<0>(wv, w_in, NIN_REAL, DM, g_pre, (bf16_t*)(ws + OFF_WIN), t, 8, tl);
        else if (t < 560) transpose_tile<1>(wv, w_uq, 1536, 512, g_q, (bf16_t*)(ws + OFF_WUQ), t - 512, 2, tl);
        else if (t < 576) transpose_tile<2>(wv, w_ukv, 2048, 256, g_kv, (bf16_t*)(ws + OFF_WK), t - 560, 1, tl);
        else if (t < 592) transpose_tile<3>(wv, w_ukv, 2048, 256, g_kv, (bf16_t*)(ws + OFF_WV), t - 576, 1, tl);
        else if (t < 720) transpose_tile<4>(wv, w_glu, 2048, 1024, nullptr, (bf16_t*)(ws + OFF_WGLU), t - 592, 4, tl);
        else transpose_tile<5>(wv, w_out, 2048, 2048, nullptr, (bf16_t*)(ws + OFF_WOUT), t - 720, 8, tl);
    }
}
__device__ __forceinline__ void prep_s5_all(int wv, const Params& p, LAS unsigned char* lds) { LIDS
    unsigned char* ws = p.ws; LAS float* tl = (LAS float*)lds;
    for (int it = gdim_l - 1 - bid_l; it < DEPTH * 64; it += gdim_l) if (it >= 0) { const int layer = it >> 6, g = it & 63;
        prep_s5_group(wv, p, layer, g, (bf16_t*)(ws + OFF_BT1 + layer * BT1_BYTES), (bf16_t*)(ws + OFF_BT2 + layer * BT2_BYTES), tl); }
    unsigned zu = 0u; asm volatile("" : "+v"(zu));
    for (int i = bid_l * 512 + tid_l; i < DEPTH * 128 * 256 / 8; i += gdim_l * 512) { const int layer = i / (128 * 256 / 8), k = i % (128 * 256 / 8);
        *(u32x4*)(ws + OFF_BT1 + layer * BT1_BYTES + (size_t)64 * 128 * 256 * 2 + (size_t)k * 16) = (u32x4){zu, zu, zu, zu}; }
}

__device__ __forceinline__ void krope_pass(int wv, const bf16_t* proj, const float* cosT, const float* sinT, bf16_t* Kf) { LIDS
    for (int idx = bid_l * 512 + tid_l; idx < SEQ * 8; idx += gdim_l * 512) {
        const int l = idx >> 3, i0 = (idx & 7) * 4;
        const u32x2 a = *(const u32x2*)(proj + (size_t)l * NIN + C_KR + i0), b = *(const u32x2*)(proj + (size_t)l * NIN + C_KR + 32 + i0);
        const f32x4 c = *(const f32x4*)(cosT + (size_t)l * 32 + i0), sn = *(const f32x4*)(sinT + (size_t)l * 32 + i0);
        const float x1[4] = {bflo(a[0]), bfhi(a[0]), bflo(a[1]), bfhi(a[1])}, x2[4] = {bflo(b[0]), bfhi(b[0]), bflo(b[1]), bfhi(b[1])};
        u32x4 w;
#pragma unroll
        for (int k = 0; k < 4; ++k) w[k] = cvt_pk_bf16(x1[k] * c[k] - x2[k] * sn[k], x2[k] * c[k] + x1[k] * sn[k]);
#pragma unroll
        for (int h = 0; h < 8; ++h) *(u32x4*)(Kf + (size_t)l * NKF + h * 192 + 128 + 2 * i0) = w;
    }
}

__device__ __forceinline__ void s5_scan(int wv, const Params& p, int layer, const float* Ebuf, bf16_t* ucat, LAS unsigned char* lds) { LIDS
    LAS float* sfin = (LAS float*)lds;
    const int tid = tid_l, chl = tid & 15, seg = tid >> 4;
    for (int it = bid_l; it < 256; it += gdim_l) {
        const int g = it >> 2, pp = (it & 3) * 16 + chl; const size_t gp = (size_t)layer * 64 + g;
        const float step = expf(p.log_step[gp]), are = p.a_re[gp * 64 + pp], aim = p.a_im[gp * 64 + pp];
        float s1, c1; sincos_rev_d(16.0 * (double)step * (double)aim, s1, c1); const float m1 = expf(16.0f * step * are); const float tr = m1 * c1, ti = m1 * s1;
        float s2, c2; sincos_rev_d(512.0 * (double)step * (double)aim, s2, c2); const float m2 = expf(512.0f * step * are); const float wr_ = m2 * c2, wi_ = m2 * s2;
        f32x2 e[32];
        const int R0 = g * NCH + seg * 32;
#pragma unroll
        for (int j = 0; j < 32; ++j) e[j] = *(const f32x2*)(Ebuf + erow_off(R0 + j) + 2 * pp);
        float sr = 0.f, si = 0.f;
#pragma unroll
        for (int j = 0; j < 32; ++j) { const float nr = tr * sr - ti * si + e[j][0], ni = tr * si + ti * sr + e[j][1]; sr = nr; si = ni; }
        __syncthreads();
        sfin[(seg * 16 + chl) * 2] = sr; sfin[(seg * 16 + chl) * 2 + 1] = si;
        __syncthreads();
        float cr_ = 0.f, ci_ = 0.f;
        for (int s = 0; s < seg; ++s) { const float fr_ = sfin[(s * 16 + chl) * 2], fi_ = sfin[(s * 16 + chl) * 2 + 1];
            const float nr = wr_ * cr_ - wi_ * ci_ + fr_, ni = wr_ * ci_ + wi_ * cr_ + fi_; cr_ = nr; ci_ = ni; }
        bf16_t* ub = ucat + ((size_t)g * NCH + seg * 32) * KCAT + 256 + 2 * pp;
#pragma unroll
        for (int j = 0; j < 32; ++j) { *(unsigned*)(ub + (size_t)j * KCAT) = cvt_pk_bf16(cr_, ci_);
            const float nr = tr * cr_ - ti * ci_ + e[j][0], ni = tr * ci_ + ti * cr_ + e[j][1]; cr_ = nr; ci_ = ni; }
    }
}

#define DSR(dst, addr, off) asm volatile("ds_read_b128 %0, %1 offset:%2" : "=v"(dst) : "v"(addr), "n"(off))
#define LGK(n, f) asm volatile("s_waitcnt lgkmcnt(%1)" : "+v"(f) : "n"(n))
constexpr int ATT_KB = 64 * 384, ATT_VB = 128 * 128, ATT_STAGE = ATT_KB + ATT_VB;
__device__ __forceinline__ void attn_phase(int wv, const bf16_t* Q, const bf16_t* Kf, const bf16_t* Vt, const bf16_t* proj, bf16_t* mixed, LAS unsigned char* lds) { LIDS
    const int tid = tid_l, wid = __builtin_amdgcn_readfirstlane(tid >> 6), lane = tid & 63, r = lane & 31, h = lane >> 5;
    unsigned koff[3], voff[2];
#pragma unroll
    for (int i = 0; i < 3; ++i) { const int j = tid + 512 * i, row = j / 24, cc = (j % 24) ^ ((row >> 1) & 7); koff[i] = (unsigned)(row * (NKF * 2) + cc * 16); }
#pragma unroll
    for (int i = 0; i < 2; ++i) { const int j = tid + 512 * i, dv = j >> 3, cc = (j & 7) ^ ((dv >> 1) & 7); voff[i] = (unsigned)dv * (unsigned)(SEQ * 2) + (unsigned)(cc * 16); }
    const int pr = (r & ~12) | ((r & 4) << 1) | ((r & 8) >> 1);
    const int kx = (pr >> 1) & 7, kxs = kx >> 1, kx0 = kx & 1;
    int koffl[4], voffl[4];
#pragma unroll
    for (int kl = 0; kl < 4; ++kl) koffl[kl] = pr * 384 + 32 * (kl ^ kxs) + 16 * (h ^ kx0);
    const int vy = (r >> 1) & 7;
#pragma unroll
    for (int c = 0; c < 4; ++c) voffl[c] = r * 128 + 16 * (((c << 1) | h) ^ vy);
    const unsigned ldsw = (unsigned)wid * 1024u;
#define ATT_ISSUE(t, b) do { const char* _kp = kbase + (size_t)(t) * (64 * NKF * 2); const char* _vp = vbase + (size_t)(t) * 128; asm volatile("" : "+s"(_kp), "+s"(_vp)); \
        _Pragma("unroll") for (int _i = 0; _i < 3; ++_i) __builtin_amdgcn_global_load_lds((const unsigned*)(_kp + koff[_i]), (LAS unsigned*)(lds + (b) * ATT_STAGE + ldsw + _i * 8192), 16, 0, 0); \
        _Pragma("unroll") for (int _i = 0; _i < 2; ++_i) __builtin_amdgcn_global_load_lds((const unsigned*)(_vp + voff[_i]), (LAS unsigned*)(lds + (b) * ATT_STAGE + ATT_KB + ldsw + _i * 8192), 16, 0, 0); } while (0)

    if (wid >= 4) __builtin_amdgcn_s_setprio(1);
    for (int it = bid_l; it < 256; it += gdim_l) {
        const int head = it & 7, pi = it >> 3;
        for (int half = 0; half < 2; ++half) {
            const int qb = half == 0 ? 63 - pi : pi;
            const int q0 = qb * 256, qw0 = q0 + 32 * wid, q = qw0 + r, nt = 4 * qb + 4;
            const char* kbase = (const char*)Kf + head * 192 * 2; const char* vbase = (const char*)Vt + (size_t)head * 128 * SEQ * 2;
            bf16x8 qf[12];
#pragma unroll
            for (int ks = 0; ks < 12; ++ks) qf[ks] = *(const bf16x8*)(Q + (size_t)q * NQ + head * 192 + ks * 16 + h * 8);
            float zf = 0.f; asm volatile("" : "+v"(zf));
            f32x16 o[4];
#pragma unroll
            for (int b = 0; b < 4; ++b)
#pragma unroll
                for (int j = 0; j < 16; ++j) o[b][j] = zf;
            float mrun = -1e30f, lsum = 0.f;
            asm volatile("" ::: "memory"); __builtin_amdgcn_s_barrier(); asm volatile("" ::: "memory");
            ATT_ISSUE(0, 0);
            for (int t = 0; t < nt; ++t) {
                const int b = t & 1;
                asm volatile("s_waitcnt vmcnt(0)" ::: "memory"); __builtin_amdgcn_s_barrier(); asm volatile("" ::: "memory");
                if (t + 1 < nt) ATT_ISSUE(t + 1, b ^ 1);
                if (64 * t <= qw0 + 31) {
                    LAS unsigned char* kb_ = lds + b * ATT_STAGE; LAS unsigned char* vb_ = kb_ + ATT_KB;
                    f32x16 s[2];
#pragma unroll
                    for (int kb = 0; kb < 2; ++kb)
#pragma unroll
                        for (int j = 0; j < 16; ++j) s[kb][j] = zf;
                    unsigned kad[4];
#pragma unroll
                    for (int kl = 0; kl < 4; ++kl) kad[kl] = (unsigned)(size_t)kb_ + (unsigned)koffl[kl];
                    bf16x8 fr_[4];
#define ATT_KRD(i) DSR(fr_[(i) & 3], kad[((i) >> 1) & 3], ((i) & 1) * (32 * 384) + ((i) >> 3) * 128)
                    ATT_KRD(0); ATT_KRD(1); ATT_KRD(2); ATT_KRD(3);
#pragma unroll
                    for (int i = 0; i < 24; ++i) {
                        LGK(i < 21 ? 3 : 23 - i, fr_[i & 3]);
                        s[i & 1] = __builtin_amdgcn_mfma_f32_32x32x16_bf16(fr_[i & 3], qf[i >> 1], s[i & 1], 0, 0, 0);
                        if (i + 4 < 24) ATT_KRD(i + 4);
                    }
#undef ATT_KRD
                    unsigned vad[4];
#pragma unroll
                    for (int c = 0; c < 4; ++c) vad[c] = (unsigned)(size_t)vb_ + (unsigned)voffl[c];
#define ATT_VRD(j) DSR(fr_[(j) & 3], vad[(j) >> 2], ((j) & 3) * 4096)
                    ATT_VRD(0); ATT_VRD(1); ATT_VRD(2); ATT_VRD(3);
                    if (64 * t + 63 > qw0) {
#pragma unroll
                        for (int kb = 0; kb < 2; ++kb)
#pragma unroll
                            for (int j = 0; j < 16; ++j) { const int key = 64 * t + 32 * kb + 16 * (j >> 3) + 8 * h + (j & 7); if (key > q) s[kb][j] = -1e30f; }
                    }
                    float mx = -1e30f;
#pragma unroll
                    for (int kb = 0; kb < 2; ++kb)
#pragma unroll
                        for (int j = 0; j < 16; ++j) mx = fmaxf(mx, s[kb][j]);
                    mx = fmaxf(mx, __shfl_xor(mx, 32));
                    if (__builtin_amdgcn_ballot_w64(mx > mrun + 8.0f) != 0ull) {
                        const float mnew = fmaxf(mrun, mx), alpha = fast_exp2(mrun - mnew); mrun = mnew;
                        lsum *= alpha;
#pragma unroll
                        for (int bb = 0; bb < 4; ++bb)
#pragma unroll
                            for (int j = 0; j < 16; ++j) o[bb][j] *= alpha;
                    }
                    float ps = 0.f;
#pragma unroll
                    for (int kb = 0; kb < 2; ++kb)
#pragma unroll
                        for (int j = 0; j < 16; ++j) { s[kb][j] = fast_exp2(s[kb][j] - mrun); ps += s[kb][j]; }
                    lsum += ps;
#pragma unroll
                    for (int c = 0; c < 4; ++c) {
                        const int kb = c >> 1, sx = c & 1;
                        u32x4 pw;
#pragma unroll
                        for (int j = 0; j < 4; ++j) pw[j] = cvt_pk_bf16(s[kb][8 * sx + 2 * j], s[kb][8 * sx + 2 * j + 1]);
                        const bf16x8 pf = __builtin_bit_cast(bf16x8, pw);
#pragma unroll
                        for (int bb = 0; bb < 4; ++bb) {
                            const int j = c * 4 + bb;
                            LGK(j < 13 ? 3 : 15 - j, fr_[j & 3]);
                            o[bb] = __builtin_amdgcn_mfma_f32_32x32x16_bf16(fr_[j & 3], pf, o[bb], 0, 0, 0);
                            if (j + 4 < 16) ATT_VRD(j + 4);
                        }
                    }
#undef ATT_VRD
                }
            }
            const float ltot = lsum + __shfl_xor(lsum, 32), inv = 1.0f / ltot;
            const int l2 = lane_id_asm(), h2 = l2 >> 5, q2 = qb * 256 + 32 * wid + (l2 & 31);
            u32x2 gwv[16];
#pragma unroll
            for (int e = 0; e < 16; ++e) gwv[e] = *(const u32x2*)(proj + (size_t)q2 * NIN + C_GM + head * 128 + 32 * (e >> 2) + 8 * (e & 3) + 4 * h2);
            __builtin_amdgcn_sched_barrier(0);
#pragma unroll
            for (int bb = 0; bb < 4; ++bb)
#pragma unroll
                for (int jp = 0; jp < 2; ++jp) {
                    u32x2 wv2[2];
#pragma unroll
                    for (int e = 0; e < 2; ++e) { const int gq = 2 * jp + e; const u32x2 gw = gwv[bb * 4 + gq];
                        wv2[e][0] = cvt_pk_bf16(o[bb][4 * gq] * inv * siluf_(bflo(gw[0])), o[bb][4 * gq + 1] * inv * siluf_(bfhi(gw[0])));
                        wv2[e][1] = cvt_pk_bf16(o[bb][4 * gq + 2] * inv * siluf_(bflo(gw[1])), o[bb][4 * gq + 3] * inv * siluf_(bfhi(gw[1]))); }
                    const auto r0 = __builtin_amdgcn_permlane32_swap(wv2[0][0], wv2[1][0], false, false);
                    const auto r1 = __builtin_amdgcn_permlane32_swap(wv2[0][1], wv2[1][1], false, false);
                    u32x4 ov; ov[0] = r0[0]; ov[1] = r1[0]; ov[2] = r0[1]; ov[3] = r1[1];
                    *(u32x4*)(mixed + (size_t)q2 * DM + head * 128 + 32 * bb + 16 * jp + 8 * h2) = ov;
                    __builtin_amdgcn_sched_barrier(0);
                }
        }
    }
    __builtin_amdgcn_s_setprio(0);
    asm volatile("s_waitcnt vmcnt(0)" ::: "memory"); __builtin_amdgcn_s_barrier(); asm volatile("" ::: "memory");
#undef ATT_ISSUE
}

#define XB_TMO      128
#define XB_XCNT(j)  (256  + 64 * (j))
#define XB_XSUB(j)  (1280 + 64 * (j))
#define XB_XGEN(j)  (2304 + 64 * (j))
#define XB_TOP      3328
#define XB_TOPGEN   3392
#define XB_SPIN_CAP (1u << 20)
__device__ __forceinline__ unsigned xb_ld(unsigned* p)              { return __hip_atomic_load(p, __ATOMIC_RELAXED, __HIP_MEMORY_SCOPE_AGENT); }
__device__ __forceinline__ unsigned xb_add(unsigned* p, unsigned v) { return __hip_atomic_fetch_add(p, v, __ATOMIC_RELAXED, __HIP_MEMORY_SCOPE_AGENT); }
__device__ __forceinline__ unsigned xb_xcc_id() { return (unsigned)__builtin_amdgcn_s_getreg((3 << 11) | 20) & 0xFu; }
#define XB_SPIN(cond, bar) do { unsigned _sp = 0; while (cond) { __builtin_amdgcn_s_sleep(1); \
    if ((++_sp & 255u) == 0u) { if (xb_ld(&(bar)[XB_TMO])) break; if (_sp > XB_SPIN_CAP) { atomicAdd(&(bar)[XB_TMO], 1u); break; } } } } while (0)
__device__ __forceinline__ void xcd_barrier_complete(unsigned* bar, unsigned x, unsigned G, unsigned& nloc, unsigned& nx) {
    unsigned sum, cnt, mine, sp = 0u;
    for (;;) {
        sum = 0u; cnt = 0u; mine = 0u;
#pragma unroll
        for (unsigned j = 0; j < 16; ++j) { const unsigned c = xb_ld(&bar[XB_XCNT(j)]); sum += c; cnt += (c > 0u) ? 1u : 0u; mine = (j == x) ? c : mine; }
        if (sum == G) break;
        __builtin_amdgcn_s_sleep(1);
        if ((++sp & 255u) == 0u) { if (xb_ld(&bar[XB_TMO])) break; if (sp > XB_SPIN_CAP) { atomicAdd(&bar[XB_TMO], 1u); break; } }
    }
    nloc = mine > 0u ? mine : 1u; nx = cnt > 0u ? cnt : 1u;
}
__device__ __forceinline__ void xcd_barrier(unsigned* bar, volatile LAS unsigned* st, bool is_t0, unsigned G) {
    asm volatile("s_waitcnt vmcnt(0)" ::: "memory");
    __syncthreads();
    if (is_t0) {
        const unsigned x = xb_xcc_id();
        __builtin_amdgcn_s_waitcnt(0);
        unsigned nloc = st[0], nx = st[1];
        if (nloc == 0u) { xcd_barrier_complete(bar, x, G, nloc, nx); st[0] = nloc; st[1] = nx; }
        const unsigned old = xb_add(&bar[XB_XSUB(x)], 1u);
        const unsigned gen = old / nloc;
        if (old + 1u == (gen + 1u) * nloc) {
            __builtin_amdgcn_fence(__ATOMIC_RELEASE, "agent");
            asm volatile("s_waitcnt vmcnt(0)" ::: "memory");
            const unsigned og = xb_add(&bar[XB_TOP], 1u);
            const unsigned tg = og / nx;
            if (og + 1u == (tg + 1u) * nx) xb_add(&bar[XB_TOPGEN], 1u);
            else XB_SPIN(xb_ld(&bar[XB_TOPGEN]) == tg, bar);
            __builtin_amdgcn_fence(__ATOMIC_ACQUIRE, "agent");
            xb_add(&bar[XB_XGEN(x)], 1u);
            asm volatile("s_waitcnt vmcnt(0)" ::: "memory");
        } else {
            XB_SPIN(xb_ld(&bar[XB_XGEN(x)]) == gen, bar);
            __builtin_amdgcn_fence(__ATOMIC_ACQUIRE, "agent");
            asm volatile("s_waitcnt vmcnt(0)" ::: "memory");
        }
    }
    __syncthreads();
}

constexpr int NPHASE = 1 + 7 * DEPTH;
__device__ __forceinline__ unsigned char* launder_p(unsigned char* x) { asm volatile("" : "+s"(x)); return x; }
#define WSP(T, off) ((T*)(p.ws + (off)))
#define PHASE_FN __device__ __forceinline__
PHASE_FN void ph_init(int wv, const Params& p, LAS unsigned char* lds) { LIDS
    const int G = gdim_l, c = bid_l;
    float* cosT = WSP(float, OFF_COS); float* sinT = WSP(float, OFF_SIN);
    for (int i = c * 512 + tid_l; i < SEQ * 32; i += G * 512) { const int l = i >> 5, k = i & 31; const float ang = (float)p.pos[l] * p.inv_freq[k]; float s, cc; sincos_rev(ang, s, cc); cosT[i] = cc; sinT[i] = s; }
    for (int step = 0; step < 2; ++step) {
        if (((step ^ c) & 1) == 0) { rowpass(wv, p.x, nullptr, nullptr, p.norm_pre, p.out, WSP(bf16_t, OFF_XN), 0); prep_layer(wv, p, 0, lds); }
        else prep_s5_all(wv, p, lds);
    }
}
PHASE_FN void ph_proj(int wv, const Params& p, int layer, LAS unsigned char* lds) { LIDS
    Gemm g{WSP(bf16_t, OFF_XN), WSP(bf16_t, OFF_WIN), DM, DM, DM, (size_t)BM * DM * 2, (size_t)BM * DM * 2, 0};
    StaticOrder S; S.init(SEQ, NIN, gdim_l, bid_l); EpiProj E{WSP(bf16_t, OFF_PROJ), WSP(bf16_t, OFF_UCAT), WSP(float, OFF_SS)};
    gemm_phase(wv, lds, g, S, E);
}
PHASE_FN void ph_q(int wv, const Params& p, int layer, LAS unsigned char* lds) { LIDS
    Gemm g{WSP(bf16_t, OFF_PROJ) + C_CQ, WSP(bf16_t, OFF_WUQ), NIN, 512, 512, (size_t)BM * NIN * 2, (size_t)BM * 512 * 2, 0};
    StaticOrder S; S.init(SEQ, NQ, gdim_l, bid_l); EpiQ E{WSP(bf16_t, OFF_Q), WSP(float, OFF_SS), WSP(float, OFF_COS), WSP(float, OFF_SIN)}; gemm_phase(wv, lds, g, S, E);
}
PHASE_FN void ph_k(int wv, const Params& p, int layer, LAS unsigned char* lds) { LIDS
    const int G = gdim_l;
    Gemm g{WSP(bf16_t, OFF_PROJ) + C_CKV, WSP(bf16_t, OFF_WK), NIN, 256, 256, (size_t)BM * NIN * 2, (size_t)BM * 256 * 2, 0};
    StaticOrder S; S.init(SEQ, 1024, G, (bid_l + G / 2) % G); EpiK E{WSP(bf16_t, OFF_KF), WSP(float, OFF_SS)}; gemm_phase(wv, lds, g, S, E);
}
PHASE_FN void ph_v(int wv, const Params& p, int layer, LAS unsigned char* lds) { LIDS
    Gemm g{WSP(bf16_t, OFF_WV), WSP(bf16_t, OFF_PROJ) + C_CKV, 256, NIN, 256, (size_t)BM * 256 * 2, (size_t)BM * NIN * 2, 0};
    StaticOrder S; S.init(1024, SEQ, gdim_l, bid_l); EpiVt E{WSP(bf16_t, OFF_VT), WSP(float, OFF_SS)}; gemm_phase(wv, lds, g, S, E);
}
PHASE_FN void ph_e(int wv, const Params& p, int layer, LAS unsigned char* lds) { LIDS
    const int G = gdim_l;
    Gemm g{WSP(bf16_t, OFF_UCAT), WSP(bf16_t, OFF_BT1 + layer * BT1_BYTES), KCAT, 256, 256, (size_t)BM * KCAT * 2, (size_t)128 * 256 * 2, 0};
    GroupOrderE S{G, bid_l}; EpiE E{WSP(float, OFF_EBUF)}; gemm_phase(wv, lds, g, S, E);
    krope_pass(wv, WSP(bf16_t, OFF_PROJ), WSP(float, OFF_COS), WSP(float, OFF_SIN), WSP(bf16_t, OFF_KF));
}
PHASE_FN void ph_scan(int wv, const Params& p, int layer, LAS unsigned char* lds) { s5_scan(wv, p, layer, WSP(float, OFF_EBUF), WSP(bf16_t, OFF_UCAT), lds); }
PHASE_FN void ph_attn(int wv, const Params& p, int layer, LAS unsigned char* lds) {
    attn_phase(wv, WSP(bf16_t, OFF_Q), WSP(bf16_t, OFF_KF), WSP(bf16_t, OFF_VT), WSP(bf16_t, OFF_PROJ), WSP(bf16_t, OFF_MIXED), lds);
}
PHASE_FN void ph_y(int wv, const Params& p, int layer, LAS unsigned char* lds) { LIDS
    Gemm g{WSP(bf16_t, OFF_UCAT), WSP(bf16_t, OFF_BT2 + layer * BT2_BYTES), KCAT, KCAT, KCAT, (size_t)BM * KCAT * 2, (size_t)BM * KCAT * 2, 0};
    GroupOrder S{gdim_l, bid_l}; EpiY E{WSP(bf16_t, OFF_YACT), WSP(bf16_t, OFF_UCAT), p.d_skip + (size_t)layer * 1024}; gemm_phase(wv, lds, g, S, E);
}
PHASE_FN void ph_glu(int wv, const Params& p, int layer, LAS unsigned char* lds) { LIDS
    Gemm g{WSP(bf16_t, OFF_YACT), WSP(bf16_t, OFF_WGLU), 1024, 1024, 1024, (size_t)BM * 32, (size_t)BM * 1024 * 2, 1};
    StaticOrder S; S.init(SEQ, 2048, gdim_l, bid_l); EpiGlu E{WSP(bf16_t, OFF_MIXED), WSP(bf16_t, OFF_PROJ)}; gemm_phase(wv, lds, g, S, E);
}
PHASE_FN void ph_out(int wv, const Params& p, int layer, LAS unsigned char* lds) { LIDS
    Gemm g{WSP(bf16_t, OFF_MIXED), WSP(bf16_t, OFF_WOUT), DM, DM, DM, (size_t)BM * DM * 2, (size_t)BM * DM * 2, 0};
    StaticOrder S; S.init(SEQ, DM, gdim_l, bid_l); EpiOut E{WSP(bf16_t, OFF_OUTB)}; gemm_phase(wv, lds, g, S, E);
}
PHASE_FN void ph_row(int wv, const Params& p, int layer, LAS unsigned char* lds) { LIDS
    rowpass(wv, layer == 0 ? p.x : p.out, WSP(bf16_t, OFF_OUTB), p.norm_post + (size_t)layer * DM, layer + 1 < DEPTH ? p.norm_pre + (size_t)(layer + 1) * DM : nullptr, p.out, WSP(bf16_t, OFF_XN), 1);
    if (layer + 1 < DEPTH) prep_layer(wv, p, layer + 1, lds);
}
__global__ void __launch_bounds__(512) hymba_megakernel(Params p) {
    extern __shared__ __attribute__((aligned(16))) unsigned char shm_raw[];
    LAS unsigned char* lds = (LAS unsigned char*)shm_raw;
    const int wv = __builtin_amdgcn_readfirstlane((int)(threadIdx.x >> 6));
    __shared__ uint4 xb_words;
    unsigned* bar = (unsigned*)(p.ws + OFF_BAR);
    if (p.coop) {
        if (threadIdx.x == 0) { xb_words = make_uint4(0u, 0u, 0u, 0u); (void)xb_add(&bar[XB_XCNT(xb_xcc_id())], 1u); }
        __syncthreads();
    }
    for (int ph = p.ph_begin; ph < p.ph_end; ++ph) {
        if (ph == 0) ph_init(wv, p, lds);
        else {
            const int layer = (ph - 1) / 7, sub = (ph - 1) % 7;
            if (sub == 0) ph_proj(wv, p, layer, lds);
            else if (sub == 1) { ph_q(wv, p, layer, lds); ph_k(wv, p, layer, lds); ph_v(wv, p, layer, lds); ph_e(wv, p, layer, lds); }
            else if (sub == 2) { ph_scan(wv, p, layer, lds); ph_attn(wv, p, layer, lds); }
            else if (sub == 3) ph_y(wv, p, layer, lds);
            else if (sub == 4) ph_glu(wv, p, layer, lds);
            else if (sub == 5) ph_out(wv, p, layer, lds);
            else ph_row(wv, p, layer, lds);
        }
        if (ph + 1 < p.ph_end && p.coop) {
            if (p.coop > 1) cg::this_grid().sync();
            else xcd_barrier(bar, (volatile LAS unsigned*)&xb_words, lane_id_asm() == 0 && wv == 0, gridDim.x);
        }
    }
}

extern "C" void kernel_launch(void* const* d_in, const int* in_sizes, int n_in, void* d_out, int out_size, void* d_ws, size_t ws_size, hipStream_t stream) {
    constexpr size_t kDynLds = STAGE_BYTES;
    static int grid_blocks = 0;
    if (!grid_blocks) {
        hipFuncSetAttribute((const void*)hymba_megakernel, hipFuncAttributeMaxDynamicSharedMemorySize, (int)kDynLds);
        int dev = 0, cus = 0, per_cu = 0;
        hipGetDevice(&dev);
        hipDeviceGetAttribute(&cus, hipDeviceAttributeMultiprocessorCount, dev);
        hipOccupancyMaxActiveBlocksPerMultiprocessor(&per_cu, hymba_megakernel, 512, kDynLds);
        if (per_cu < 1) per_cu = 1;
        grid_blocks = cus * per_cu; if (grid_blocks > 256) grid_blocks = 256;
    }
    if (ws_size < WS_NEED) { fprintf(stderr, "workspace too small: %zu < %zu\n", ws_size, (size_t)WS_NEED); }
    Params p; memset(&p, 0, sizeof(p));
    p.x = (const float*)d_in[0]; p.pos = (const int*)d_in[1]; p.norm_pre = (const float*)d_in[2]; p.norm_post = (const float*)d_in[3]; p.w_in = (const float*)d_in[4];
    p.q_norm = (const float*)d_in[5]; p.w_uq = (const float*)d_in[6]; p.kv_norm = (const float*)d_in[7]; p.w_ukv = (const float*)d_in[8];
    p.a_re = (const float*)d_in[9]; p.a_im = (const float*)d_in[10]; p.b_re = (const float*)d_in[11]; p.b_im = (const float*)d_in[12]; p.c_re = (const float*)d_in[13]; p.c_im = (const float*)d_in[14];
    p.d_skip = (const float*)d_in[15]; p.log_step = (const float*)d_in[16]; p.w_glu = (const float*)d_in[17]; p.w_out = (const float*)d_in[18];
    p.out = (float*)d_out; p.ws = (unsigned char*)d_ws;
    for (int i = 0; i < 32; ++i) p.inv_freq[i] = (float)std::pow(10000.0, -(double)i / 32.0);
#ifdef MULTI_LAUNCH
    for (int ph = 0; ph < NPHASE; ++ph) { p.ph_begin = ph; p.ph_end = ph + 1; p.coop = 0; hipLaunchKernelGGL(hymba_megakernel, dim3(grid_blocks), dim3(512), kDynLds, stream, p); }
#else
    p.ph_begin = 0; p.ph_end = NPHASE; p.coop = 1;
    (void)hipMemsetAsync((unsigned char*)d_ws + OFF_BAR, 0, BAR_BYTES, stream);
    void* args[] = {&p};
    hipError_t e = hipLaunchCooperativeKernel((void*)hymba_megakernel, dim3(grid_blocks), dim3(512), args, kDynLds, stream);
    if (e != hipSuccess) fprintf(stderr, "cooperative launch failed: %s (grid %d)\n", hipGetErrorString(e), grid_blocks);
#endif
}
```

```cpp
#include <hip/hip_runtime.h>
#include <hip/hip_cooperative_groups.h>
#include <cstdio>
#include <cstring>
#include <cmath>
namespace cg = cooperative_groups;

#define LAS __attribute__((address_space(3)))
typedef unsigned short bf16_t;
typedef short bf16x8 __attribute__((ext_vector_type(8)));
typedef float f32x4 __attribute__((ext_vector_type(4)));
typedef float f32x2 __attribute__((ext_vector_type(2)));
typedef float f32x16 __attribute__((ext_vector_type(16)));
typedef unsigned u32x4 __attribute__((ext_vector_type(4)));
typedef unsigned u32x2 __attribute__((ext_vector_type(2)));

constexpr int SEQ = 16384, DM = 2048, NIN = 4096  , NIN_REAL = 3904, DEPTH = 4;
constexpr int C_CQ = 0, C_CKV = 512, C_KR = 768, C_GM = 832, C_U = 1856, C_GS = 2880;
constexpr int NQ = 1536, NKF = 1536;
constexpr int TCH = 16, NCH = SEQ / TCH  , KCAT = 384;
constexpr float EPS = 1e-6f;

constexpr size_t OFF_XN = 0;
constexpr size_t OFF_MIXED = 0;
constexpr size_t OFF_PROJ = OFF_XN + (size_t)SEQ * DM * 2;
constexpr size_t OFF_UCAT = OFF_PROJ + (size_t)SEQ * NIN * 2;
constexpr size_t OFF_Q = OFF_UCAT + (size_t)64 * NCH * KCAT * 2;
constexpr size_t OFF_YACT = OFF_Q;
constexpr size_t OFF_KF = OFF_Q + (size_t)SEQ * NQ * 2;
constexpr size_t OFF_VT = OFF_KF + (size_t)SEQ * NKF * 2;
constexpr size_t OFF_OUTB = OFF_KF;
constexpr size_t OFF_EBUF = OFF_XN;
constexpr size_t OFF_WIN = OFF_VT + (size_t)1024 * SEQ * 2;
constexpr size_t OFF_WUQ = OFF_WIN + (size_t)NIN * DM * 2;
constexpr size_t OFF_WK = OFF_WUQ + (size_t)1536 * 512 * 2;
constexpr size_t OFF_WV = OFF_WK + (size_t)1024 * 256 * 2;
constexpr size_t OFF_WGLU = OFF_WV + (size_t)1024 * 256 * 2;
constexpr size_t OFF_WOUT = OFF_WGLU + (size_t)2048 * 1024 * 2;
constexpr size_t OFF_BT1 = OFF_WOUT + (size_t)2048 * 2048 * 2;
constexpr size_t BT1_BYTES = (size_t)(64 * 128 + 128) * 256 * 2, BT2_BYTES = (size_t)64 * 256 * KCAT * 2;
constexpr size_t OFF_BT2 = OFF_BT1 + DEPTH * BT1_BYTES;
constexpr size_t OFF_COS = OFF_BT2 + DEPTH * BT2_BYTES;
constexpr size_t OFF_SIN = OFF_COS + (size_t)SEQ * 32 * 4;
constexpr size_t OFF_SS = OFF_SIN + (size_t)SEQ * 32 * 4;
constexpr size_t OFF_BAR = OFF_SS + (size_t)SEQ * 16 * 4;
constexpr size_t BAR_BYTES = 3456 * 4;
constexpr size_t WS_NEED = OFF_BAR + BAR_BYTES;

struct Params {
    const float* x; const int* pos; const float* norm_pre; const float* norm_post; const float* w_in; const float* q_norm; const float* w_uq;
    const float* kv_norm; const float* w_ukv; const float* a_re; const float* a_im; const float* b_re; const float* b_im; const float* c_re;
    const float* c_im; const float* d_skip; const float* log_step; const float* w_glu; const float* w_out;
    float* out; unsigned char* ws; unsigned long long pad0;
    float inv_freq[32];
    int ph_begin, ph_end, coop, pad1;
};

__device__ __forceinline__ unsigned cvt_pk_bf16(float lo, float hi) { unsigned r; asm volatile("v_cvt_pk_bf16_f32 %0, %1, %2" : "=v"(r) : "v"(lo), "v"(hi)); return r; }
__device__ __forceinline__ float bf2f(unsigned short b) { return __uint_as_float(((unsigned)b) << 16); }
__device__ __forceinline__ float bflo(unsigned w) { return __uint_as_float(w << 16); }
__device__ __forceinline__ float bfhi(unsigned w) { return __uint_as_float(w & 0xffff0000u); }
__device__ __forceinline__ u32x4 pack8(f32x4 a, f32x4 b) { u32x4 r; r[0] = cvt_pk_bf16(a[0], a[1]); r[1] = cvt_pk_bf16(a[2], a[3]); r[2] = cvt_pk_bf16(b[0], b[1]); r[3] = cvt_pk_bf16(b[2], b[3]); return r; }
__device__ __forceinline__ size_t erow_off(int R) { return (size_t)(R >> 2) * 1024 + 512 + (size_t)(R & 3) * 128; }
__device__ __forceinline__ float fast_exp2(float x) { return __builtin_amdgcn_exp2f(x); }
__device__ __forceinline__ float fast_rcp(float x) { return __builtin_amdgcn_rcpf(x); }
__device__ __forceinline__ float sigmoidf_(float x) { return fast_rcp(1.0f + fast_exp2(-1.4426950408889634f * x)); }
__device__ __forceinline__ float siluf_(float x) { return x * sigmoidf_(x); }
__device__ __forceinline__ float gelu_tanh(float x) {
    const float u = 0.7978845608028654f * (x + 0.044715f * x * x * x);
    return x * sigmoidf_(2.0f * u);
}
__device__ __forceinline__ void sincos_rev_d(double ang, float& s, float& c) {
    double rev = ang * 0.15915494309189533577; rev -= rint(rev);
    const float f = (float)rev; s = __builtin_amdgcn_sinf(f); c = __builtin_amdgcn_cosf(f);
}
__device__ __forceinline__ void sincos_rev(float ang, float& s, float& c) {
    double rev = (double)ang * 0.15915494309189533577; rev -= rint(rev);
    const float f = (float)rev; s = __builtin_amdgcn_sinf(f); c = __builtin_amdgcn_cosf(f);
}

__device__ __forceinline__ int launder_v(int x) { asm volatile("" : "+v"(x)); return x; }
__device__ __forceinline__ int launder_s(int x) { asm volatile("" : "+s"(x)); return x; }
__device__ __forceinline__ int lane_id_asm() { int x; asm volatile("v_mbcnt_lo_u32_b32 %0, -1, 0\n\tv_mbcnt_hi_u32_b32 %0, -1, %0" : "=&v"(x)); return x; }
#define TID() (launder_s(wv) * 64 + lane_id_asm())
#define BID() launder_s((int)blockIdx.x)
#define GDIM() launder_s((int)gridDim.x)
#define LIDS const int tid_l = TID(), bid_l = BID(), gdim_l = GDIM(); (void)tid_l; (void)bid_l; (void)gdim_l;
constexpr int BM = 256, BK = 64, HALF = 128, HTB = HALF * BK * 2, STAGE_BYTES = 8 * HTB, NXCD = 8, WGM = 8;
__device__ __forceinline__ int lds_byte(int r, int c) { const int st = (r >> 4) * 2 + (c >> 5), rr = r & 15, cc = c & 31, ob = rr * 64 + cc * 2; return st * 1024 + (ob ^ (((ob >> 9) & 1) << 5)); }
__device__ __forceinline__ void stage_rc(int b, int& R, int& C) { const int st = b / 1024, sb = b % 1024, swz = sb ^ (((sb >> 9) & 1) << 5); R = (st >> 1) * 16 + swz / 64; C = (st & 1) * 32 + (swz % 64) / 2; }
__device__ __forceinline__ int perm32(int rho) { const int n = rho >> 4, i = rho & 15; return 8 * (i >> 2) + 4 * n + (i & 3); }

struct Unit { int pm, pn; };
struct Gemm { const bf16_t* A; const bf16_t* Bt; int lda, ldb, K; size_t tstepA, tstepB; int amode; };

struct StaticOrder {
    int nM, nN, nwg, G, c;
    __device__ void init(int M, int N, int G_, int c_) { nM = M / BM; nN = N / BM; nwg = nM * nN; G = G_; c = c_; }
    __device__ bool next(int i, Unit& u) const {
        const long L = (long)i * G + c; if (L >= nwg) return false;
        int wgid = (int)L; { const int q = nwg / NXCD, r = nwg % NXCD, xcd = wgid % NXCD, off = wgid / NXCD; wgid = (xcd < r ? xcd * (q + 1) : r * (q + 1) + (xcd - r) * q) + off; }
        const int nig = WGM * nN, gid = wgid / nig, fm = gid * WGM, gsz = (nM - fm) < WGM ? (nM - fm) : WGM;
        u.pm = fm + ((wgid % nig) % gsz); u.pn = (wgid % nig) / gsz; return true;
    }
};
struct GroupOrderE {
    int G, c;
    __device__ bool next(int i, Unit& u) const { int idx; if (G == 256) { if (c < 128 || i >= 2) return false; const int xcd = c & 7, k2 = ((c - 128) >> 3) * 2 + i; idx = (xcd * 8 + (k2 >> 2)) * 4 + (k2 & 3); } else { idx = i * G + ((c + G / 2) % G); if (idx >= 256) return false; }
        u.pm = idx; u.pn = idx >> 2; return true; }
};
struct GroupOrder {
    int G, c;
    __device__ bool next(int i, Unit& u) const { int idx = i * G + c; if (idx >= 256) return false;
        if (G == 256) { const int xcd = c & 7, k = c >> 3; idx = (xcd * 8 + (k >> 2)) * 4 + (k & 3); }
        u.pm = idx; u.pn = idx >> 2; return true; }
};

template <class Epi, class Sched>
__device__ __forceinline__ void gemm_phase(int wv, LAS unsigned char* lds, const Gemm g, const Sched& S, const Epi& E) { LIDS
    const int tid = tid_l, wid = __builtin_amdgcn_readfirstlane(tid >> 6), lane = tid & 63, wr = wid >> 2, wc = wid & 3, fr = lane & 15, fq = lane >> 4;
    const int K = g.K, nt = K / BK;
    unsigned voffA, voffB;
    { int R, C; stage_rc(tid * 16, R, C); const int Rb = (R & ~31) + perm32(R & 31);
      voffA = g.amode ? (unsigned)((C >> 4) * (SEQ * 16) + R * 16 + (C & 15)) * 2u : (unsigned)(R * g.lda + C) * 2u; voffB = (unsigned)(Rb * g.ldb + C) * 2u; }
    const size_t rowA = g.amode ? (size_t)32 : (size_t)g.lda * 2;
    const size_t voffA_q = 64 * rowA, voffB_q = (size_t)64 * g.ldb * 2;
    const size_t kstepA = g.amode ? (size_t)4 * SEQ * 32 : (size_t)(BK * 2), kstepB = (size_t)(BK * 2);
    const size_t hstepA = HALF * rowA, hstepB = (size_t)HALF * g.ldb * 2;
    const unsigned ldsw = (unsigned)wid * 1024u;
    const int aoff = lds_byte(wr * 64 + fr, fq * 8), boff = lds_byte(wc * 32 + fr, fq * 8);
#define PG8_SA(b, h) (((b) * 2 + (h)) * HTB)
#define PG8_SB(b, h) ((4 + (b) * 2 + (h)) * HTB)
#define PG8_STAGE(bufoff, gbase, voff) do { _Pragma("unroll") for (int _i = 0; _i < 2; ++_i) { const char* _gb = (const char*)(gbase) + (size_t)_i * (voff##_q); asm volatile("" : "+s"(_gb)); \
        __builtin_amdgcn_global_load_lds((const unsigned*)(_gb + (voff)), (LAS unsigned*)(lds + (bufoff) + ldsw + _i * 8192), 16, 0, 0); } } while (0)
#define PG8_LDA(dst, b, h) do { _Pragma("unroll") for (int m = 0; m < 4; ++m) _Pragma("unroll") for (int k = 0; k < 2; ++k) dst[m][k] = *(const LAS bf16x8*)(lds + PG8_SA(b, h) + aoff + m * 2048 + k * 1024); } while (0)
#define PG8_LDB(dst, b, h) do { _Pragma("unroll") for (int n = 0; n < 2; ++n) _Pragma("unroll") for (int k = 0; k < 2; ++k) dst[n][k] = *(const LAS bf16x8*)(lds + PG8_SB(b, h) + boff + n * 2048 + k * 1024); } while (0)
#define PG8_MMA(ai, bj, At, Bt) do { __builtin_amdgcn_s_setprio(1); _Pragma("unroll") for (int m = 0; m < 4; ++m) _Pragma("unroll") for (int n = 0; n < 2; ++n) _Pragma("unroll") for (int k = 0; k < 2; ++k) \
        acc[ai][bj][m][n] = __builtin_amdgcn_mfma_f32_16x16x32_bf16(Bt[n][k], At[m][k], acc[ai][bj][m][n], 0, 0, 0); __builtin_amdgcn_s_setprio(0); } while (0)
#define PG8_WAIT_V(n) asm volatile("s_waitcnt vmcnt(" #n ")" ::: "memory")
#define PG8_WAIT_L(n) asm volatile("s_waitcnt lgkmcnt(" #n ")" ::: "memory")
#define PG8_BAR __builtin_amdgcn_s_barrier()
#define PG8_SCHED __builtin_amdgcn_sched_barrier(0)
    Unit cur, nxt; int ui = 0;
    if (!S.next(0, cur)) return;
    float zf = 0.f; asm volatile("" : "+v"(zf)); const f32x4 zero4 = (f32x4){zf, zf, zf, zf};
    f32x4 acc[2][2][4][2];
#pragma unroll
    for (int a = 0; a < 2; ++a)
#pragma unroll
        for (int b = 0; b < 2; ++b)
#pragma unroll
            for (int m = 0; m < 4; ++m)
#pragma unroll
                for (int n = 0; n < 2; ++n) acc[a][b][m][n] = zero4;
    bf16x8 At[4][2], B0[2][2], B1[2][2];
    const char* cA = (const char*)g.A + (size_t)cur.pm * g.tstepA; const char* cB = (const char*)g.Bt + (size_t)cur.pn * g.tstepB;
    PG8_STAGE(PG8_SB(0, 0), cB, voffB); PG8_STAGE(PG8_SA(0, 0), cA, voffA); PG8_STAGE(PG8_SB(0, 1), cB + hstepB, voffB); PG8_STAGE(PG8_SA(0, 1), cA + hstepA, voffA);
    if (wr == 1) PG8_BAR;
    PG8_WAIT_V(4); PG8_BAR;
    PG8_STAGE(PG8_SB(1, 0), cB + kstepB, voffB); PG8_STAGE(PG8_SA(1, 0), cA + kstepA, voffA); PG8_STAGE(PG8_SB(1, 1), cB + hstepB + kstepB, voffB);
    PG8_WAIT_V(6); PG8_BAR;
    for (;;) {
        const bool has_next = S.next(ui + 1, nxt);
        const char* nA = has_next ? (const char*)g.A + (size_t)nxt.pm * g.tstepA : cA; const char* nB = has_next ? (const char*)g.Bt + (size_t)nxt.pn * g.tstepB : cB;
        for (int t = 0; t < nt; t += 2) {
            const bool last = (t == nt - 2);
            const char* a1 = cA + (size_t)(t + 1) * kstepA;
            const char* a2 = last ? nA : cA + (size_t)(t + 2) * kstepA; const char* b2 = last ? nB : cB + (size_t)(t + 2) * kstepB;
            const char* a3 = a2 + kstepA; const char* b3 = b2 + kstepB;
            asm volatile("" : "+s"(a1), "+s"(a2), "+s"(b2), "+s"(a3), "+s"(b3));
            PG8_LDB(B0, 0, 0); PG8_SCHED; PG8_LDA(At, 0, 0); PG8_STAGE(PG8_SA(1, 1), a1 + hstepA, voffA);
            PG8_WAIT_L(8); PG8_BAR; PG8_WAIT_L(0); PG8_MMA(0, 0, At, B0); PG8_BAR; PG8_SCHED;
            PG8_LDB(B1, 0, 1); PG8_STAGE(PG8_SB(0, 0), b2, voffB);
            PG8_BAR; PG8_WAIT_L(0); PG8_MMA(0, 1, At, B1); PG8_BAR;
            PG8_LDA(At, 0, 1); PG8_STAGE(PG8_SA(0, 0), a2, voffA);
            PG8_BAR; PG8_WAIT_L(0); PG8_MMA(1, 0, At, B0); PG8_BAR; PG8_SCHED;
            PG8_STAGE(PG8_SB(0, 1), b2 + hstepB, voffB);
            PG8_WAIT_V(6); PG8_BAR; PG8_MMA(1, 1, At, B1); PG8_BAR;
            PG8_LDB(B0, 1, 0); PG8_SCHED; PG8_LDA(At, 1, 0); PG8_STAGE(PG8_SA(0, 1), a2 + hstepA, voffA);
            PG8_WAIT_L(8); PG8_BAR; PG8_WAIT_L(0); PG8_MMA(0, 0, At, B0); PG8_BAR; PG8_SCHED;
            PG8_LDB(B1, 1, 1); PG8_STAGE(PG8_SB(1, 0), b3, voffB);
            PG8_BAR; PG8_WAIT_L(0); PG8_MMA(0, 1, At, B1); PG8_BAR;
            PG8_LDA(At, 1, 1); PG8_STAGE(PG8_SA(1, 0), a3, voffA);
            PG8_BAR; PG8_WAIT_L(0); PG8_MMA(1, 0, At, B0); PG8_BAR; PG8_SCHED;
            PG8_STAGE(PG8_SB(1, 1), b3 + hstepB, voffB);
            PG8_WAIT_V(6); PG8_BAR; PG8_MMA(1, 1, At, B1); PG8_BAR;
        }
        { const int l2 = lane_id_asm(); E(acc, cur, wr, wc, l2 & 15, l2 >> 4); }
        if (!has_next) break;
#pragma unroll
        for (int a = 0; a < 2; ++a)
#pragma unroll
            for (int b = 0; b < 2; ++b)
#pragma unroll
                for (int m = 0; m < 4; ++m)
#pragma unroll
                    for (int n = 0; n < 2; ++n) acc[a][b][m][n] = zero4;
        cur = nxt; cA = nA; cB = nB; ++ui;
    }
    PG8_WAIT_V(0);
    if (wr == 0) PG8_BAR;
    PG8_BAR;
#undef PG8_SA
#undef PG8_SB
#undef PG8_STAGE
#undef PG8_LDA
#undef PG8_LDB
#undef PG8_MMA
#undef PG8_WAIT_V
#undef PG8_WAIT_L
#undef PG8_BAR
#undef PG8_SCHED
}

typedef f32x4 AccT[2][2][4][2];
#define EPI_ROWS(u) const int row0 = (u).pm * BM + wr * 64 + fr; const int colbase = (u).pn * BM + wc * 32 + 8 * fq;

struct EpiProj {
    bf16_t* proj; bf16_t* ucat; float* ssp;
    __device__ __forceinline__ void operator()(const AccT& acc, const Unit& u, int wr, int wc, int fr, int fq) const {
        EPI_ROWS(u)
        const bool do_ss = (u.pn <= 2);
#pragma unroll
        for (int ai = 0; ai < 2; ++ai)
#pragma unroll
            for (int m = 0; m < 4; ++m) {
                const int row = row0 + ai * HALF + m * 16; float ss = 0.f;
#pragma unroll
                for (int bj = 0; bj < 2; ++bj) {
                    const int col = colbase + bj * HALF; const f32x4 v0 = acc[ai][bj][m][0], v1 = acc[ai][bj][m][1];
                    const u32x4 pk = pack8(v0, v1);
                    if (col >= C_U && col < C_GS) { const int ch = col - C_U, gg = ch >> 4, hh = ch & 15;
                        *(u32x4*)(ucat + ((size_t)(gg * NCH + (row >> 4)) * KCAT + (row & 15) * 16 + hh)) = pk; }
                    else if (col < NIN_REAL) *(u32x4*)(proj + (size_t)row * NIN + col) = pk;
                    if (do_ss) ss += v0[0] * v0[0] + v0[1] * v0[1] + v0[2] * v0[2] + v0[3] * v0[3] + v1[0] * v1[0] + v1[1] * v1[1] + v1[2] * v1[2] + v1[3] * v1[3];
                }
                __builtin_amdgcn_sched_barrier(0);
                if (do_ss) { ss += __shfl_xor(ss, 16); ss += __shfl_xor(ss, 32); if (fq == 0) ssp[(size_t)row * 16 + u.pn * 4 + wc] = ss; }
            }
    }
};
struct EpiQ {
    bf16_t* Q; const float* ssp; const float* cosT; const float* sinT;
    __device__ __forceinline__ void operator()(const AccT& acc, const Unit& u, int wr, int wc, int fr, int fq) const {
        EPI_ROWS(u)
#pragma unroll
        for (int ai = 0; ai < 2; ++ai)
#pragma unroll
            for (int m = 0; m < 4; ++m) {
                const int row = row0 + ai * HALF + m * 16;
                const f32x4 pa = *(const f32x4*)(ssp + (size_t)row * 16), pb = *(const f32x4*)(ssp + (size_t)row * 16 + 4);
                const float ssr = ((pa[0] + pa[1]) + (pa[2] + pa[3])) + ((pb[0] + pb[1]) + (pb[2] + pb[3]));
                const float sc = rsqrtf(ssr * (1.0f / 512.0f) + EPS) * (1.4426950408889634f * 0.07216878364870322f);
#pragma unroll
                for (int bj = 0; bj < 2; ++bj) {
                    const int col = colbase + bj * HALF; f32x4 v0 = acc[ai][bj][m][0], v1 = acc[ai][bj][m][1];
                    const int d = col % 192;
                    if (d >= 128) { const int i0 = (d - 128) >> 1;
                        const f32x4 c4 = *(const f32x4*)(cosT + (size_t)row * 32 + i0), s4 = *(const f32x4*)(sinT + (size_t)row * 32 + i0);
                        f32x4 o0, o1;
                        o0[0] = v0[0] * c4[0] - v0[1] * s4[0]; o0[1] = v0[1] * c4[0] + v0[0] * s4[0];
                        o0[2] = v0[2] * c4[1] - v0[3] * s4[1]; o0[3] = v0[3] * c4[1] + v0[2] * s4[1];
                        o1[0] = v1[0] * c4[2] - v1[1] * s4[2]; o1[1] = v1[1] * c4[2] + v1[0] * s4[2];
                        o1[2] = v1[2] * c4[3] - v1[3] * s4[3]; o1[3] = v1[3] * c4[3] + v1[2] * s4[3];
                        v0 = o0; v1 = o1; }
                    *(u32x4*)(Q + (size_t)row * NQ + col) = pack8(v0 * sc, v1 * sc); __builtin_amdgcn_sched_barrier(0);
                }
            }
    }
};
struct EpiK {
    bf16_t* Kf; const float* ssp;
    __device__ __forceinline__ void operator()(const AccT& acc, const Unit& u, int wr, int wc, int fr, int fq) const {
        EPI_ROWS(u)
#pragma unroll
        for (int ai = 0; ai < 2; ++ai)
#pragma unroll
            for (int m = 0; m < 4; ++m) {
                const int row = row0 + ai * HALF + m * 16;
                const f32x4 pc = *(const f32x4*)(ssp + (size_t)row * 16 + 8);
                const float sc = rsqrtf(((pc[0] + pc[1]) + (pc[2] + pc[3])) * (1.0f / 256.0f) + EPS);
#pragma unroll
                for (int bj = 0; bj < 2; ++bj) {
                    const int col = colbase + bj * HALF, head = col >> 7, d = col & 127;
                    *(u32x4*)(Kf + (size_t)row * NKF + head * 192 + d) = pack8(acc[ai][bj][m][0] * sc, acc[ai][bj][m][1] * sc);
                }
            }
    }
};
struct EpiVt {
    bf16_t* Vt; const float* ssp;
    __device__ __forceinline__ void operator()(const AccT& acc, const Unit& u, int wr, int wc, int fr, int fq) const {
        EPI_ROWS(u)
#pragma unroll
        for (int bj = 0; bj < 2; ++bj) {
            const int col = colbase + bj * HALF;
            f32x4 s0, s1;
#pragma unroll
            for (int j = 0; j < 4; ++j) { const f32x4 pc = *(const f32x4*)(ssp + (size_t)(col + j) * 16 + 8), pd = *(const f32x4*)(ssp + (size_t)(col + 4 + j) * 16 + 8);
                s0[j] = rsqrtf(((pc[0] + pc[1]) + (pc[2] + pc[3])) * (1.0f / 256.0f) + EPS); s1[j] = rsqrtf(((pd[0] + pd[1]) + (pd[2] + pd[3])) * (1.0f / 256.0f) + EPS); }
#pragma unroll
            for (int ai = 0; ai < 2; ++ai)
#pragma unroll
                for (int m = 0; m < 4; ++m) {
                    const int row = row0 + ai * HALF + m * 16;
                    *(u32x4*)(Vt + (size_t)row * SEQ + col) = pack8(acc[ai][bj][m][0] * s0, acc[ai][bj][m][1] * s1);
                }
        }
    }
};
struct EpiE {
    float* Ebuf;
    __device__ __forceinline__ void operator()(const AccT& acc, const Unit& u, int wr, int wc, int fr, int fq) const {
        const int row0 = u.pm * BM + wr * 64 + fr, cc = wc * 32 + 8 * fq;
#pragma unroll
        for (int ai = 0; ai < 2; ++ai)
#pragma unroll
            for (int m = 0; m < 4; ++m) {
                const int row = row0 + ai * HALF + m * 16;
                *(f32x4*)(Ebuf + erow_off(row) + cc) = acc[ai][0][m][0]; *(f32x4*)(Ebuf + erow_off(row) + cc + 4) = acc[ai][0][m][1];
            }
    }
};
struct EpiY {
    bf16_t* Yact; const bf16_t* ucat; const float* dskip;
    __device__ __forceinline__ void operator()(const AccT& acc, const Unit& u, int wr, int wc, int fr, int fq) const {
        const int row0 = u.pm * BM + wr * 64 + fr, g = u.pn;
#pragma unroll
        for (int bj = 0; bj < 2; ++bj) {
            const int n = bj * HALF + wc * 32 + 8 * fq, t = n >> 4, hh = n & 15;
            const f32x4 d0 = *(const f32x4*)(dskip + g * 16 + hh), d1 = *(const f32x4*)(dskip + g * 16 + hh + 4);
            u32x4 uv[8];
#pragma unroll
            for (int rr = 0; rr < 8; ++rr) uv[rr] = *(const u32x4*)(ucat + (size_t)(row0 + (rr >> 2) * HALF + (rr & 3) * 16) * KCAT + n);
            __builtin_amdgcn_sched_barrier(0);
#pragma unroll
            for (int ai = 0; ai < 2; ++ai)
#pragma unroll
                for (int m = 0; m < 4; ++m) {
                    const int R = row0 + ai * HALF + m * 16;
                    const u32x4 uu = uv[ai * 4 + m];
                    f32x4 y0 = acc[ai][bj][m][0], y1 = acc[ai][bj][m][1];
                    y0[0] += d0[0] * bflo(uu[0]); y0[1] += d0[1] * bfhi(uu[0]); y0[2] += d0[2] * bflo(uu[1]); y0[3] += d0[3] * bfhi(uu[1]);
                    y1[0] += d1[0] * bflo(uu[2]); y1[1] += d1[1] * bfhi(uu[2]); y1[2] += d1[2] * bflo(uu[3]); y1[3] += d1[3] * bfhi(uu[3]);
#pragma unroll
                    for (int j = 0; j < 4; ++j) { y0[j] = gelu_tanh(y0[j]); y1[j] = gelu_tanh(y1[j]); }
                    *(u32x4*)(Yact + (size_t)R * 256 + n) = pack8(y0, y1); __builtin_amdgcn_sched_barrier(0);
                }
        }
    }
};
struct EpiGlu {
    bf16_t* mixed; const bf16_t* proj;
    __device__ __forceinline__ void operator()(const AccT& acc, const Unit& u, int wr, int wc, int fr, int fq) const {
        const int row0 = u.pm * BM + wr * 64 + fr, ch = u.pn * 128 + wc * 32 + 8 * fq;
        u32x4 gsv[8];
#pragma unroll
        for (int rr = 0; rr < 8; ++rr) gsv[rr] = *(const u32x4*)(proj + (size_t)(row0 + (rr >> 2) * HALF + (rr & 3) * 16) * NIN + C_GS + ch);
        __builtin_amdgcn_sched_barrier(0);
#pragma unroll
        for (int ai = 0; ai < 2; ++ai)
#pragma unroll
            for (int m = 0; m < 4; ++m) {
                const int row = row0 + ai * HALF + m * 16;
#pragma unroll
                for (int n = 0; n < 2; ++n) {
                    const unsigned g_lo = gsv[ai * 4 + m][2 * n], g_hi = gsv[ai * 4 + m][2 * n + 1];
                    const f32x4 a0 = acc[ai][0][m][n], g0 = acc[ai][1][m][n];
                    const float o0 = a0[0] * sigmoidf_(g0[0]) * siluf_(bflo(g_lo)), o1 = a0[1] * sigmoidf_(g0[1]) * siluf_(bfhi(g_lo));
                    const float o2 = a0[2] * sigmoidf_(g0[2]) * siluf_(bflo(g_hi)), o3 = a0[3] * sigmoidf_(g0[3]) * siluf_(bfhi(g_hi));
                    u32x2 w; w[0] = cvt_pk_bf16(o0, o1); w[1] = cvt_pk_bf16(o2, o3);
                    *(u32x2*)(mixed + (size_t)row * DM + 1024 + ch + 4 * n) = w;
                    __builtin_amdgcn_sched_barrier(0);
                }
            }
    }
};
struct EpiOut {
    bf16_t* outb;
    __device__ __forceinline__ void operator()(const AccT& acc, const Unit& u, int wr, int wc, int fr, int fq) const {
        EPI_ROWS(u)
#pragma unroll
        for (int ai = 0; ai < 2; ++ai)
#pragma unroll
            for (int m = 0; m < 4; ++m) {
                const int row = row0 + ai * HALF + m * 16;
#pragma unroll
                for (int bj = 0; bj < 2; ++bj) *(u32x4*)(outb + (size_t)row * DM + colbase + bj * HALF) = pack8(acc[ai][bj][m][0], acc[ai][bj][m][1]);
            }
    }
};

__device__ __forceinline__ float wave_sum(float v) {
#pragma unroll
    for (int o = 32; o >= 1; o >>= 1) v += __shfl_xor(v, o);
    return v;
}
__device__ __forceinline__ void rowpass(int wv, const float* xin, const bf16_t* outb, const float* g_post, const float* g_pre_next, float* xres, bf16_t* xn, int mode) { LIDS
    const int lane = tid_l & 63, wid = tid_l >> 6;
#define RP_OFF(i) (((i) >> 1) * 512 + lane * 8 + ((i) & 1) * 4)
    for (int row = bid_l * 8 + wid; row < SEQ; row += gdim_l * 8) {
        f32x4 xv[8]; float ss = 0.f;
        if (mode == 0) {
#pragma unroll
            for (int i = 0; i < 8; ++i) xv[i] = __builtin_nontemporal_load((const f32x4*)(xin + (size_t)row * DM + RP_OFF(i)));
        } else {
            f32x4 ov[8]; float so = 0.f;
#pragma unroll
            for (int ip = 0; ip < 4; ++ip) { const u32x4 w = __builtin_nontemporal_load((const u32x4*)(outb + (size_t)row * DM + ip * 512 + lane * 8));
                ov[2 * ip][0] = bflo(w[0]); ov[2 * ip][1] = bfhi(w[0]); ov[2 * ip][2] = bflo(w[1]); ov[2 * ip][3] = bfhi(w[1]);
                ov[2 * ip + 1][0] = bflo(w[2]); ov[2 * ip + 1][1] = bfhi(w[2]); ov[2 * ip + 1][2] = bflo(w[3]); ov[2 * ip + 1][3] = bfhi(w[3]); }
#pragma unroll
            for (int i = 0; i < 8; ++i) so += ov[i][0] * ov[i][0] + ov[i][1] * ov[i][1] + ov[i][2] * ov[i][2] + ov[i][3] * ov[i][3];
            so = wave_sum(so); const float inv = rsqrtf(so * (1.0f / DM) + EPS);
#pragma unroll
            for (int i = 0; i < 8; ++i) { const f32x4 xo = __builtin_nontemporal_load((const f32x4*)(xin + (size_t)row * DM + RP_OFF(i))); const f32x4 gp = *(const f32x4*)(g_post + RP_OFF(i));
                xv[i] = xo + ov[i] * inv * gp; }
        }
#pragma unroll
        for (int i = 0; i < 8; ++i) { if (mode != 0) __builtin_nontemporal_store(xv[i], (f32x4*)(xres + (size_t)row * DM + RP_OFF(i)));
            ss += xv[i][0] * xv[i][0] + xv[i][1] * xv[i][1] + xv[i][2] * xv[i][2] + xv[i][3] * xv[i][3]; }
        if (g_pre_next) {
            ss = wave_sum(ss); const float inv = rsqrtf(ss * (1.0f / DM) + EPS);
#pragma unroll
            for (int ip = 0; ip < 4; ++ip) { const f32x4 g0 = *(const f32x4*)(g_pre_next + RP_OFF(2 * ip)), g1 = *(const f32x4*)(g_pre_next + RP_OFF(2 * ip + 1));
                const f32x4 y0 = xv[2 * ip] * inv * g0, y1 = xv[2 * ip + 1] * inv * g1;
                *(u32x4*)(xn + (size_t)row * DM + ip * 512 + lane * 8) = pack8(y0, y1); }
        }
    }
#undef RP_OFF
}

template <int MAP> __device__ __forceinline__ int wmap(int n) {
    if (MAP == 0) return n < NIN_REAL ? n : -1;
    if (MAP == 1) { const int head = n / 192, d = n % 192; if (d < 128) return n; const int e = d - 128; return head * 192 + 128 + (e & 1) * 32 + (e >> 1); }
    if (MAP == 2) return (n >> 7) * 256 + (n & 127);
    if (MAP == 3) return (n >> 7) * 256 + 128 + (n & 127);
    if (MAP == 4) { const int pn = n >> 8, r = n & 255; return r < 128 ? pn * 128 + r : 1024 + pn * 128 + (r - 128); }
    return n;
}
template <int MAP> __device__ __forceinline__ void transpose_tile(int wv, const float* src, int ldsrc, int K, const float* gain, bf16_t* dst, int tile, int ktiles, LAS float* tl) { LIDS
    const int n0 = (tile / ktiles) * 64, k0 = (tile % ktiles) * 256, tx = tid_l & 63, ty = tid_l >> 6;
    const int sc = wmap<MAP>(n0 + tx);
    float v[32];
#pragma unroll
    for (int i = 0; i < 32; ++i) { const int k = k0 + ty + 8 * i; v[i] = (sc >= 0) ? __builtin_nontemporal_load(src + (size_t)k * ldsrc + sc) : 0.f; }
    if (gain) {
#pragma unroll
        for (int i = 0; i < 32; ++i) v[i] *= gain[k0 + ty + 8 * i];
    }
#pragma unroll
    for (int i = 0; i < 32; ++i) tl[(ty + 8 * i) * 65 + tx] = v[i];
    __syncthreads();
    {
        const int r = tid_l >> 3;
#pragma unroll
        for (int q = 0; q < 4; ++q) { const int kq = (tid_l & 7) * 8 + 64 * q; f32x4 a, b;
#pragma unroll
            for (int jj = 0; jj < 4; ++jj) { a[jj] = tl[(kq + jj) * 65 + r]; b[jj] = tl[(kq + 4 + jj) * 65 + r]; }
            *(u32x4*)(dst + (size_t)(n0 + r) * K + k0 + kq) = pack8(a, b); }
    }
    __syncthreads();
}
__device__ __forceinline__ void prep_s5_group(int wv, const Params& p, int layer, int g, bf16_t* bt1, bf16_t* bt2, LAS float* L) { LIDS
    LAS float* apr = L; LAS float* api = apr + 17 * 64; LAS float* bbr = api + 17 * 64; LAS float* bbi = bbr + 1024; LAS float* cr = bbi + 1024; LAS float* ci = cr + 1024; LAS float* kt = ci + 1024;
    const int tid = tid_l; const size_t gp = (size_t)layer * 64 + g;
    const float step = expf(p.log_step[gp]);
    for (int i = tid; i < 17 * 64; i += 512) { const int d = i >> 6, pp = i & 63; const float are = p.a_re[gp * 64 + pp], aim = p.a_im[gp * 64 + pp];
        const float mag = expf((float)d * step * are); float s, c; sincos_rev_d((double)d * (double)step * (double)aim, s, c); apr[i] = mag * c; api[i] = mag * s; }
    for (int i = tid; i < 1024; i += 512) { const int hh = i >> 6, pp = i & 63; cr[i] = p.c_re[(gp * 16 + hh) * 64 + pp]; ci[i] = p.c_im[(gp * 16 + hh) * 64 + pp]; }
    __syncthreads();
    for (int i = tid; i < 1024; i += 512) { const int pp = i >> 4; const float are = p.a_re[gp * 64 + pp], aim = p.a_im[gp * 64 + pp];
        const float xr = apr[64 + pp] - 1.0f, xi = api[64 + pp], den = 1.0f / (are * are + aim * aim);
        const float qr = (xr * are + xi * aim) * den, qi = (xi * are - xr * aim) * den;
        const float br = p.b_re[gp * 1024 + i], bi = p.b_im[gp * 1024 + i];
        bbr[i] = qr * br - qi * bi; bbi[i] = qr * bi + qi * br; }
    __syncthreads();
    {
        const int i0 = tid * 8, d = i0 >> 8, hh = (i0 >> 4) & 15, h20 = i0 & 15; float acc8[8];
#pragma unroll
        for (int e = 0; e < 8; ++e) acc8[e] = 0.f;
        for (int pp = 0; pp < 64; ++pp) { const float wr_ = cr[hh * 64 + pp] * apr[d * 64 + pp] - ci[hh * 64 + pp] * api[d * 64 + pp], wi_ = cr[hh * 64 + pp] * api[d * 64 + pp] + ci[hh * 64 + pp] * apr[d * 64 + pp];
#pragma unroll
            for (int e = 0; e < 8; ++e) acc8[e] += wr_ * bbr[pp * 16 + h20 + e] - wi_ * bbi[pp * 16 + h20 + e]; }
#pragma unroll
        for (int e = 0; e < 8; ++e) kt[i0 + e] = acc8[e]; }
    __syncthreads();
    for (int i = tid; i < 256 * KCAT; i += 512) { const int n = i / KCAT, k = i % KCAT, t = n >> 4, hh = n & 15; float v;
        if (k < 256) { const int s = k >> 4, h2 = k & 15; v = (s <= t) ? kt[((t - s) * 16 + hh) * 16 + h2] : 0.f; }
        else { const int pp = (k - 256) >> 1, ri = k & 1, d = t + 1; const float fr_ = cr[hh * 64 + pp] * apr[d * 64 + pp] - ci[hh * 64 + pp] * api[d * 64 + pp], fi_ = cr[hh * 64 + pp] * api[d * 64 + pp] + ci[hh * 64 + pp] * apr[d * 64 + pp];
            v = ri ? -fi_ : fr_; }
        bt2[(size_t)g * 256 * KCAT + i] = (bf16_t)(cvt_pk_bf16(v, 0.f) & 0xffffu); }
    for (int i = tid; i < 128 * 256; i += 512) { const int n = i >> 8, k = i & 255, pp = n >> 1, ri = n & 1, t = k >> 4, hh = k & 15, d = 15 - t;
        const float er = apr[d * 64 + pp] * bbr[pp * 16 + hh] - api[d * 64 + pp] * bbi[pp * 16 + hh], ei = apr[d * 64 + pp] * bbi[pp * 16 + hh] + api[d * 64 + pp] * bbr[pp * 16 + hh];
        bt1[(size_t)g * 128 * 256 + i] = (bf16_t)(cvt_pk_bf16(ri ? ei : er, 0.f) & 0xffffu); }
    __syncthreads();
}
__device__ __forceinline__ void prep_layer(int wv, const Params& p, int layer, LAS unsigned char* lds) { LIDS
    unsigned char* ws = p.ws; LAS float* tl = (LAS float*)lds;
    const float* w_in = p.w_in + (size_t)layer * DM * NIN_REAL; const float* w_uq = p.w_uq + (size_t)layer * 512 * 1536; const float* w_ukv = p.w_ukv + (size_t)layer * 256 * 2048;
    const float* w_glu = p.w_glu + (size_t)layer * 1024 * 2048; const float* w_out = p.w_out + (size_t)layer * 2048 * 2048;
    const float* g_pre = nullptr;
    const float* g_q = p.q_norm + layer * 512; const float* g_kv = p.kv_norm + layer * 256;
    for (int t = bid_l; t < 976; t += gdim_l) {
        if (t < 512) transpose_tile<0>(wv, w_in, NIN_REAL, DM, g_pre, (bf16_t*)(ws + OFF_WIN), t, 8, tl);
        else if (t < 560) transpose_tile<1>(wv, w_uq, 1536, 512, g_q, (bf16_t*)(ws + OFF_WUQ), t - 512, 2, tl);
        else if (t < 576) transpose_tile<2>(wv, w_ukv, 2048, 256, g_kv, (bf16_t*)(ws + OFF_WK), t - 560, 1, tl);
        else if (t < 592) transpose_tile<3>(wv, w_ukv, 2048, 256, g_kv, (bf16_t*)(ws + OFF_WV), t - 576, 1, tl);
        else if (t < 720) transpose_tile<4>(wv, w_glu, 2048, 1024, nullptr, (bf16_t*)(ws + OFF_WGLU), t - 592, 4, tl);
        else transpose_tile<5>(wv, w_out, 2048, 2048, nullptr, (bf16_t*)(ws + OFF_WOUT), t - 720, 8, tl);
    }
}
__device__ __forceinline__ void prep_s5_all(int wv, const Params& p, LAS unsigned char* lds) { LIDS
    unsigned char* ws = p.ws; LAS float* tl = (LAS float*)lds;
    for (int it = gdim_l - 1 - bid_l; it < DEPTH * 64; it += gdim_l) if (it >= 0) { const int layer = it >> 6, g = it & 63;
        prep_s5_group(wv, p, layer, g, (bf16_t*)(ws + OFF_BT1 + layer * BT1_BYTES), (bf16_t*)(ws + OFF_BT2 + layer * BT2_BYTES), tl); }
    unsigned zu = 0u; asm volatile("" : "+v"(zu));
    for (int i = bid_l * 512 + tid_l; i < DEPTH * 128 * 256 / 8; i += gdim_l * 512) { const int layer = i / (128 * 256 / 8), k = i % (128 * 256 / 8);
        *(u32x4*)(ws + OFF_BT1 + layer * BT1_BYTES + (size_t)64 * 128 * 256 * 2 + (size_t)k * 16) = (u32x4){zu, zu, zu, zu}; }
}

__device__ __forceinline__ void krope_pass(int wv, const bf16_t* proj, const float* cosT, const float* sinT, bf16_t* Kf) { LIDS
    for (int idx = bid_l * 512 + tid_l; idx < SEQ * 8; idx += gdim_l * 512) {
        const int l = idx >> 3, i0 = (idx & 7) * 4;
        const u32x2 a = *(const u32x2*)(proj + (size_t)l * NIN + C_KR + i0), b = *(const u32x2*)(proj + (size_t)l * NIN + C_KR + 32 + i0);
        const f32x4 c = *(const f32x4*)(cosT + (size_t)l * 32 + i0), sn = *(const f32x4*)(sinT + (size_t)l * 32 + i0);
        const float x1[4] = {bflo(a[0]), bfhi(a[0]), bflo(a[1]), bfhi(a[1])}, x2[4] = {bflo(b[0]), bfhi(b[0]), bflo(b[1]), bfhi(b[1])};
        u32x4 w;
#pragma unroll
        for (int k = 0; k < 4; ++k) w[k] = cvt_pk_bf16(x1[k] * c[k] - x2[k] * sn[k], x2[k] * c[k] + x1[k] * sn[k]);
#pragma unroll
        for (int h = 0; h < 8; ++h) *(u32x4*)(Kf + (size_t)l * NKF + h * 192 + 128 + 2 * i0) = w;
    }
}

__device__ __forceinline__ void s5_scan(int wv, const Params& p, int layer, const float* Ebuf, bf16_t* ucat, LAS unsigned char* lds) { LIDS
    LAS float* sfin = (LAS float*)lds;
    const int tid = tid_l, chl = tid & 15, seg = tid >> 4;
    for (int it = bid_l; it < 256; it += gdim_l) {
        const int g = it >> 2, pp = (it & 3) * 16 + chl; const size_t gp = (size_t)layer * 64 + g;
        const float step = expf(p.log_step[gp]), are = p.a_re[gp * 64 + pp], aim = p.a_im[gp * 64 + pp];
        float s1, c1; sincos_rev_d(16.0 * (double)step * (double)aim, s1, c1); const float m1 = expf(16.0f * step * are); const float tr = m1 * c1, ti = m1 * s1;
        float s2, c2; sincos_rev_d(512.0 * (double)step * (double)aim, s2, c2); const float m2 = expf(512.0f * step * are); const float wr_ = m2 * c2, wi_ = m2 * s2;
        f32x2 e[32];
        const int R0 = g * NCH + seg * 32;
#pragma unroll
        for (int j = 0; j < 32; ++j) e[j] = *(const f32x2*)(Ebuf + erow_off(R0 + j) + 2 * pp);
        float sr = 0.f, si = 0.f;
#pragma unroll
        for (int j = 0; j < 32; ++j) { const float nr = tr * sr - ti * si + e[j][0], ni = tr * si + ti * sr + e[j][1]; sr = nr; si = ni; }
        __syncthreads();
        sfin[(seg * 16 + chl) * 2] = sr; sfin[(seg * 16 + chl) * 2 + 1] = si;
        __syncthreads();
        float cr_ = 0.f, ci_ = 0.f;
        for (int s = 0; s < seg; ++s) { const float fr_ = sfin[(s * 16 + chl) * 2], fi_ = sfin[(s * 16 + chl) * 2 + 1];
            const float nr = wr_ * cr_ - wi_ * ci_ + fr_, ni = wr_ * ci_ + wi_ * cr_ + fi_; cr_ = nr; ci_ = ni; }
        bf16_t* ub = ucat + ((size_t)g * NCH + seg * 32) * KCAT + 256 + 2 * pp;
#pragma unroll
        for (int j = 0; j < 32; ++j) { *(unsigned*)(ub + (size_t)j * KCAT) = cvt_pk_bf16(cr_, ci_);
            const float nr = tr * cr_ - ti * ci_ + e[j][0], ni = tr * ci_ + ti * cr_ + e[j][1]; cr_ = nr; ci_ = ni; }
    }
}

#define DSR(dst, addr, off) asm volatile("ds_read_b128 %0, %1 offset:%2" : "=v"(dst) : "v"(addr), "n"(off))
#define LGK(n, f) asm volatile("s_waitcnt lgkmcnt(%1)" : "+v"(f) : "n"(n))
constexpr int ATT_KB = 64 * 384, ATT_VB = 128 * 128, ATT_STAGE = ATT_KB + ATT_VB;
__device__ __forceinline__ void attn_phase(int wv, const bf16_t* Q, const bf16_t* Kf, const bf16_t* Vt, const bf16_t* proj, bf16_t* mixed, LAS unsigned char* lds) { LIDS
    const int tid = tid_l, wid = __builtin_amdgcn_readfirstlane(tid >> 6), lane = tid & 63, r = lane & 31, h = lane >> 5;
    unsigned koff[3], voff[2];
#pragma unroll
    for (int i = 0; i < 3; ++i) { const int j = tid + 512 * i, row = j / 24, cc = (j % 24) ^ ((row >> 1) & 7); koff[i] = (unsigned)(row * (NKF * 2) + cc * 16); }
#pragma unroll
    for (int i = 0; i < 2; ++i) { const int j = tid + 512 * i, dv = j >> 3, cc = (j & 7) ^ ((dv >> 1) & 7); voff[i] = (unsigned)dv * (unsigned)(SEQ * 2) + (unsigned)(cc * 16); }
    const int pr = (r & ~12) | ((r & 4) << 1) | ((r & 8) >> 1);
    const int kx = (pr >> 1) & 7, kxs = kx >> 1, kx0 = kx & 1;
    int koffl[4], voffl[4];
#pragma unroll
    for (int kl = 0; kl < 4; ++kl) koffl[kl] = pr * 384 + 32 * (kl ^ kxs) + 16 * (h ^ kx0);
    const int vy = (r >> 1) & 7;
#pragma unroll
    for (int c = 0; c < 4; ++c) voffl[c] = r * 128 + 16 * (((c << 1) | h) ^ vy);
    const unsigned ldsw = (unsigned)wid * 1024u;
#define ATT_ISSUE(t, b) do { const char* _kp = kbase + (size_t)(t) * (64 * NKF * 2); const char* _vp = vbase + (size_t)(t) * 128; asm volatile("" : "+s"(_kp), "+s"(_vp)); \
        _Pragma("unroll") for (int _i = 0; _i < 3; ++_i) __builtin_amdgcn_global_load_lds((const unsigned*)(_kp + koff[_i]), (LAS unsigned*)(lds + (b) * ATT_STAGE + ldsw + _i * 8192), 16, 0, 0); \
        _Pragma("unroll") for (int _i = 0; _i < 2; ++_i) __builtin_amdgcn_global_load_lds((const unsigned*)(_vp + voff[_i]), (LAS unsigned*)(lds + (b) * ATT_STAGE + ATT_KB + ldsw + _i * 8192), 16, 0, 0); } while (0)

    if (wid >= 4) __builtin_amdgcn_s_setprio(1);
    for (int it = bid_l; it < 256; it += gdim_l) {
        const int head = it & 7, pi = it >> 3;
        for (int half = 0; half < 2; ++half) {
            const int qb = half == 0 ? 63 - pi : pi;
            const int q0 = qb * 256, qw0 = q0 + 32 * wid, q = qw0 + r, nt = 4 * qb + 4;
            const char* kbase = (const char*)Kf + head * 192 * 2; const char* vbase = (const char*)Vt + (size_t)head * 128 * SEQ * 2;
            bf16x8 qf[12];
#pragma unroll
            for (int ks = 0; ks < 12; ++ks) qf[ks] = *(const bf16x8*)(Q + (size_t)q * NQ + head * 192 + ks * 16 + h * 8);
            float zf = 0.f; asm volatile("" : "+v"(zf));
            f32x16 o[4];
#pragma unroll
            for (int b = 0; b < 4; ++b)
#pragma unroll
                for (int j = 0; j < 16; ++j) o[b][j] = zf;
            float mrun = -1e30f, lsum = 0.f;
            asm volatile("" ::: "memory"); __builtin_amdgcn_s_barrier(); asm volatile("" ::: "memory");
            ATT_ISSUE(0, 0);
            for (int t = 0; t < nt; ++t) {
                const int b = t & 1;
                asm volatile("s_waitcnt vmcnt(0)" ::: "memory"); __builtin_amdgcn_s_barrier(); asm volatile("" ::: "memory");
                if (t + 1 < nt) ATT_ISSUE(t + 1, b ^ 1);
                if (64 * t <= qw0 + 31) {
                    LAS unsigned char* kb_ = lds + b * ATT_STAGE; LAS unsigned char* vb_ = kb_ + ATT_KB;
                    f32x16 s[2];
#pragma unroll
                    for (int kb = 0; kb < 2; ++kb)
#pragma unroll
                        for (int j = 0; j < 16; ++j) s[kb][j] = zf;
                    unsigned kad[4];
#pragma unroll
                    for (int kl = 0; kl < 4; ++kl) kad[kl] = (unsigned)(size_t)kb_ + (unsigned)koffl[kl];
                    bf16x8 fr_[4];
#define ATT_KRD(i) DSR(fr_[(i) & 3], kad[((i) >> 1) & 3], ((i) & 1) * (32 * 384) + ((i) >> 3) * 128)
                    ATT_KRD(0); ATT_KRD(1); ATT_KRD(2); ATT_KRD(3);
#pragma unroll
                    for (int i = 0; i < 24; ++i) {
                        LGK(i < 21 ? 3 : 23 - i, fr_[i & 3]);
                        s[i & 1] = __builtin_amdgcn_mfma_f32_32x32x16_bf16(fr_[i & 3], qf[i >> 1], s[i & 1], 0, 0, 0);
                        if (i + 4 < 24) ATT_KRD(i + 4);
                    }
#undef ATT_KRD
                    unsigned vad[4];
#pragma unroll
                    for (int c = 0; c < 4; ++c) vad[c] = (unsigned)(size_t)vb_ + (unsigned)voffl[c];
#define ATT_VRD(j) DSR(fr_[(j) & 3], vad[(j) >> 2], ((j) & 3) * 4096)
                    ATT_VRD(0); ATT_VRD(1); ATT_VRD(2); ATT_VRD(3);
                    if (64 * t + 63 > qw0) {
#pragma unroll
                        for (int kb = 0; kb < 2; ++kb)
#pragma unroll
                            for (int j = 0; j < 16; ++j) { const int key = 64 * t + 32 * kb + 16 * (j >> 3) + 8 * h + (j & 7); if (key > q) s[kb][j] = -1e30f; }
                    }
                    float mx = -1e30f;
#pragma unroll
                    for (int kb = 0; kb < 2; ++kb)
#pragma unroll
                        for (int j = 0; j < 16; ++j) mx = fmaxf(mx, s[kb][j]);
                    mx = fmaxf(mx, __shfl_xor(mx, 32));
                    if (__builtin_amdgcn_ballot_w64(mx > mrun + 8.0f) != 0ull) {
                        const float mnew = fmaxf(mrun, mx), alpha = fast_exp2(mrun - mnew); mrun = mnew;
                        lsum *= alpha;
#pragma unroll
                        for (int bb = 0; bb < 4; ++bb)
#pragma unroll
                            for (int j = 0; j < 16; ++j) o[bb][j] *= alpha;
                    }
                    float ps = 0.f;
#pragma unroll
                    for (int kb = 0; kb < 2; ++kb)
#pragma unroll
                        for (int j = 0; j < 16; ++j) { s[kb][j] = fast_exp2(s[kb][j] - mrun); ps += s[kb][j]; }
                    lsum += ps;
#pragma unroll
                    for (int c = 0; c < 4; ++c) {
                        const int kb = c >> 1, sx = c & 1;
                        u32x4 pw;
#pragma unroll
                        for (int j = 0; j < 4; ++j) pw[j] = cvt_pk_bf16(s[kb][8 * sx + 2 * j], s[kb][8 * sx + 2 * j + 1]);
                        const bf16x8 pf = __builtin_bit_cast(bf16x8, pw);
#pragma unroll
                        for (int bb = 0; bb < 4; ++bb) {
                            const int j = c * 4 + bb;
                            LGK(j < 13 ? 3 : 15 - j, fr_[j & 3]);
                            o[bb] = __builtin_amdgcn_mfma_f32_32x32x16_bf16(fr_[j & 3], pf, o[bb], 0, 0, 0);
                            if (j + 4 < 16) ATT_VRD(j + 4);
                        }
                    }
#undef ATT_VRD
                }
            }
            const float ltot = lsum + __shfl_xor(lsum, 32), inv = 1.0f / ltot;
            const int l2 = lane_id_asm(), h2 = l2 >> 5, q2 = qb * 256 + 32 * wid + (l2 & 31);
            u32x2 gwv[16];
#pragma unroll
            for (int e = 0; e < 16; ++e) gwv[e] = *(const u32x2*)(proj + (size_t)q2 * NIN + C_GM + head * 128 + 32 * (e >> 2) + 8 * (e & 3) + 4 * h2);
            __builtin_amdgcn_sched_barrier(0);
#pragma unroll
            for (int bb = 0; bb < 4; ++bb)
#pragma unroll
                for (int jp = 0; jp < 2; ++jp) {
                    u32x2 wv2[2];
#pragma unroll
                    for (int e = 0; e < 2; ++e) { const int gq = 2 * jp + e; const u32x2 gw = gwv[bb * 4 + gq];
                        wv2[e][0] = cvt_pk_bf16(o[bb][4 * gq] * inv * siluf_(bflo(gw[0])), o[bb][4 * gq + 1] * inv * siluf_(bfhi(gw[0])));
                        wv2[e][1] = cvt_pk_bf16(o[bb][4 * gq + 2] * inv * siluf_(bflo(gw[1])), o[bb][4 * gq + 3] * inv * siluf_(bfhi(gw[1]))); }
                    const auto r0 = __builtin_amdgcn_permlane32_swap(wv2[0][0], wv2[1][0], false, false);
                    const auto r1 = __builtin_amdgcn_permlane32_swap(wv2[0][1], wv2[1][1], false, false);
                    u32x4 ov; ov[0] = r0[0]; ov[1] = r1[0]; ov[2] = r0[1]; ov[3] = r1[1];
                    *(u32x4*)(mixed + (size_t)q2 * DM + head * 128 + 32 * bb + 16 * jp + 8 * h2) = ov;
                    __builtin_amdgcn_sched_barrier(0);
                }
        }
    }
    __builtin_amdgcn_s_setprio(0);
    asm volatile("s_waitcnt vmcnt(0)" ::: "memory"); __builtin_amdgcn_s_barrier(); asm volatile("" ::: "memory");
#undef ATT_ISSUE
}

#define XB_TMO      128
#define XB_XCNT(j)  (256  + 64 * (j))
#define XB_XSUB(j)  (1280 + 64 * (j))
#define XB_XGEN(j)  (2304 + 64 * (j))
#define XB_TOP      3328
#define XB_TOPGEN   3392
#define XB_SPIN_CAP (1u << 20)
__device__ __forceinline__ unsigned xb_ld(unsigned* p)              { return __hip_atomic_load(p, __ATOMIC_RELAXED, __HIP_MEMORY_SCOPE_AGENT); }
__device__ __forceinline__ unsigned xb_add(unsigned* p, unsigned v) { return __hip_atomic_fetch_add(p, v, __ATOMIC_RELAXED, __HIP_MEMORY_SCOPE_AGENT); }
__device__ __forceinline__ unsigned xb_xcc_id() { return (unsigned)__builtin_amdgcn_s_getreg((3 << 11) | 20) & 0xFu; }
#define XB_SPIN(cond, bar) do { unsigned _sp = 0; while (cond) { __builtin_amdgcn_s_sleep(1); \
    if ((++_sp & 255u) == 0u) { if (xb_ld(&(bar)[XB_TMO])) break; if (_sp > XB_SPIN_CAP) { atomicAdd(&(bar)[XB_TMO], 1u); break; } } } } while (0)
__device__ __forceinline__ void xcd_barrier_complete(unsigned* bar, unsigned x, unsigned G, unsigned& nloc, unsigned& nx) {
    unsigned sum, cnt, mine, sp = 0u;
    for (;;) {
        sum = 0u; cnt = 0u; mine = 0u;
#pragma unroll
        for (unsigned j = 0; j < 16; ++j) { const unsigned c = xb_ld(&bar[XB_XCNT(j)]); sum += c; cnt += (c > 0u) ? 1u : 0u; mine = (j == x) ? c : mine; }
        if (sum == G) break;
        __builtin_amdgcn_s_sleep(1);
        if ((++sp & 255u) == 0u) { if (xb_ld(&bar[XB_TMO])) break; if (sp > XB_SPIN_CAP) { atomicAdd(&bar[XB_TMO], 1u); break; } }
    }
    nloc = mine > 0u ? mine : 1u; nx = cnt > 0u ? cnt : 1u;
}
__device__ __forceinline__ void xcd_barrier(unsigned* bar, volatile LAS unsigned* st, bool is_t0, unsigned G) {
    asm volatile("s_waitcnt vmcnt(0)" ::: "memory");
    __syncthreads();
    if (is_t0) {
        const unsigned x = xb_xcc_id();
        __builtin_amdgcn_s_waitcnt(0);
        unsigned nloc = st[0], nx = st[1];
        if (nloc == 0u) { xcd_barrier_complete(bar, x, G, nloc, nx); st[0] = nloc; st[1] = nx; }
        const unsigned old = xb_add(&bar[XB_XSUB(x)], 1u);
        const unsigned gen = old / nloc;
        if (old + 1u == (gen + 1u) * nloc) {
            __builtin_amdgcn_fence(__ATOMIC_RELEASE, "agent");
            asm volatile("s_waitcnt vmcnt(0)" ::: "memory");
            const unsigned og = xb_add(&bar[XB_TOP], 1u);
            const unsigned tg = og / nx;
            if (og + 1u == (tg + 1u) * nx) xb_add(&bar[XB_TOPGEN], 1u);
            else XB_SPIN(xb_ld(&bar[XB_TOPGEN]) == tg, bar);
            __builtin_amdgcn_fence(__ATOMIC_ACQUIRE, "agent");
            xb_add(&bar[XB_XGEN(x)], 1u);
            asm volatile("s_waitcnt vmcnt(0)" ::: "memory");
        } else {
            XB_SPIN(xb_ld(&bar[XB_XGEN(x)]) == gen, bar);
            __builtin_amdgcn_fence(__ATOMIC_ACQUIRE, "agent");
            asm volatile("s_waitcnt vmcnt(0)" ::: "memory");
        }
    }
    __syncthreads();
}

constexpr int NPHASE = 1 + 7 * DEPTH;
__device__ __forceinline__ unsigned char* launder_p(unsigned char* x) { asm volatile("" : "+s"(x)); return x; }
#define WSP(T, off) ((T*)(p.ws + (off)))
#define PHASE_FN __device__ __forceinline__
PHASE_FN void ph_init(int wv, const Params& p, LAS unsigned char* lds) { LIDS
    const int G = gdim_l, c = bid_l;
    float* cosT = WSP(float, OFF_COS); float* sinT = WSP(float, OFF_SIN);
    for (int i = c * 512 + tid_l; i < SEQ * 32; i += G * 512) { const int l = i >> 5, k = i & 31; const float ang = (float)p.pos[l] * p.inv_freq[k]; float s, cc; sincos_rev(ang, s, cc); cosT[i] = cc; sinT[i] = s; }
    for (int step = 0; step < 2; ++step) {
        if (((step ^ c) & 1) == 0) { rowpass(wv, p.x, nullptr, nullptr, p.norm_pre, p.out, WSP(bf16_t, OFF_XN), 0); prep_layer(wv, p, 0, lds); }
        else prep_s5_all(wv, p, lds);
    }
}
PHASE_FN void ph_proj(int wv, const Params& p, int layer, LAS unsigned char* lds) { LIDS
    Gemm g{WSP(bf16_t, OFF_XN), WSP(bf16_t, OFF_WIN), DM, DM, DM, (size_t)BM * DM * 2, (size_t)BM * DM * 2, 0};
    StaticOrder S; S.init(SEQ, NIN, gdim_l, bid_l); EpiProj E{WSP(bf16_t, OFF_PROJ), WSP(bf16_t, OFF_UCAT), WSP(float, OFF_SS)};
    gemm_phase(wv, lds, g, S, E);
}
PHASE_FN void ph_q(int wv, const Params& p, int layer, LAS unsigned char* lds) { LIDS
    Gemm g{WSP(bf16_t, OFF_PROJ) + C_CQ, WSP(bf16_t, OFF_WUQ), NIN, 512, 512, (size_t)BM * NIN * 2, (size_t)BM * 512 * 2, 0};
    StaticOrder S; S.init(SEQ, NQ, gdim_l, bid_l); EpiQ E{WSP(bf16_t, OFF_Q), WSP(float, OFF_SS), WSP(float, OFF_COS), WSP(float, OFF_SIN)}; gemm_phase(wv, lds, g, S, E);
}
PHASE_FN void ph_k(int wv, const Params& p, int layer, LAS unsigned char* lds) { LIDS
    const int G = gdim_l;
    Gemm g{WSP(bf16_t, OFF_PROJ) + C_CKV, WSP(bf16_t, OFF_WK), NIN, 256, 256, (size_t)BM * NIN * 2, (size_t)BM * 256 * 2, 0};
    StaticOrder S; S.init(SEQ, 1024, G, (bid_l + G / 2) % G); EpiK E{WSP(bf16_t, OFF_KF), WSP(float, OFF_SS)}; gemm_phase(wv, lds, g, S, E);
}
PHASE_FN void ph_v(int wv, const Params& p, int layer, LAS unsigned char* lds) { LIDS
    Gemm g{WSP(bf16_t, OFF_WV), WSP(bf16_t, OFF_PROJ) + C_CKV, 256, NIN, 256, (size_t)BM * 256 * 2, (size_t)BM * NIN * 2, 0};
    StaticOrder S; S.init(1024, SEQ, gdim_l, bid_l); EpiVt E{WSP(bf16_t, OFF_VT), WSP(float, OFF_SS)}; gemm_phase(wv, lds, g, S, E);
}
PHASE_FN void ph_e(int wv, const Params& p, int layer, LAS unsigned char* lds) { LIDS
    const int G = gdim_l;
    Gemm g{WSP(bf16_t, OFF_UCAT), WSP(bf16_t, OFF_BT1 + layer * BT1_BYTES), KCAT, 256, 256, (size_t)BM * KCAT * 2, (size_t)128 * 256 * 2, 0};
    GroupOrderE S{G, bid_l}; EpiE E{WSP(float, OFF_EBUF)}; gemm_phase(wv, lds, g, S, E);
    krope_pass(wv, WSP(bf16_t, OFF_PROJ), WSP(float, OFF_COS), WSP(float, OFF_SIN), WSP(bf16_t, OFF_KF));
}
PHASE_FN void ph_scan(int wv, const Params& p, int layer, LAS unsigned char* lds) { s5_scan(wv, p, layer, WSP(float, OFF_EBUF), WSP(bf16_t, OFF_UCAT), lds); }
PHASE_FN void ph_attn(int wv, const Params& p, int layer, LAS unsigned char* lds) {
    attn_phase(wv, WSP(bf16_t, OFF_Q), WSP(bf16_t, OFF_KF), WSP(bf16_t, OFF_VT), WSP(bf16_t, OFF_PROJ), WSP(bf16_t, OFF_MIXED), lds);
}
PHASE_FN void ph_y(int wv, const Params& p, int layer, LAS unsigned char* lds) { LIDS
    Gemm g{WSP(bf16_t, OFF_UCAT), WSP(bf16_t, OFF_BT2 + layer * BT2_BYTES), KCAT, KCAT, KCAT, (size_t)BM * KCAT * 2, (size_t)BM * KCAT * 2, 0};
    GroupOrder S{gdim_l, bid_l}; EpiY E{WSP(bf16_t, OFF_YACT), WSP(bf16_t, OFF_UCAT), p.d_skip + (size_t)layer * 1024}; gemm_phase(wv, lds, g, S, E);
}
PHASE_FN void ph_glu(int wv, const Params& p, int layer, LAS unsigned char* lds) { LIDS
    Gemm g{WSP(bf16_t, OFF_YACT), WSP(bf16_t, OFF_WGLU), 1024, 1024, 1024, (size_t)BM * 32, (size_t)BM * 1024 * 2, 1};
    StaticOrder S; S.init(SEQ, 2048, gdim_l, bid_l); EpiGlu E{WSP(bf16_t, OFF_MIXED), WSP(bf16_t, OFF_PROJ)}; gemm_phase(wv, lds, g, S, E);
}
PHASE_FN void ph_out(int wv, const Params& p, int layer, LAS unsigned char* lds) { LIDS
    Gemm g{WSP(bf16_t, OFF_MIXED), WSP(bf16_t, OFF_WOUT), DM, DM, DM, (size_t)BM * DM * 2, (size_t)BM * DM * 2, 0};
    StaticOrder S; S.init(SEQ, DM, gdim_l, bid_l); EpiOut E{WSP(bf16_t, OFF_OUTB)}; gemm_phase(wv, lds, g, S, E);
}
PHASE_FN void ph_row(int wv, const Params& p, int layer, LAS unsigned char* lds) { LIDS
    rowpass(wv, layer == 0 ? p.x : p.out, WSP(bf16_t, OFF_OUTB), p.norm_post + (size_t)layer * DM, layer + 1 < DEPTH ? p.norm_pre + (size_t)(layer + 1) * DM : nullptr, p.out, WSP(bf16_t, OFF_XN), 1);
    if (layer + 1 < DEPTH) prep_layer(wv, p, layer + 1, lds);
}
__global__ void __launch_bounds__(512) hymba_megakernel(Params p) {
    extern __shared__ __attribute__((aligned(16))) unsigned char shm_raw[];
    LAS unsigned char* lds = (LAS unsigned char*)shm_raw;
    const int wv = __builtin_amdgcn_readfirstlane((int)(threadIdx.x >> 6));
    __shared__ uint4 xb_words;
    unsigned* bar = (unsigned*)(p.ws + OFF_BAR);
    if (p.coop) {
        if (threadIdx.x == 0) { xb_words = make_uint4(0u, 0u, 0u, 0u); (void)xb_add(&bar[XB_XCNT(xb_xcc_id())], 1u); }
        __syncthreads();
    }
    for (int ph = p.ph_begin; ph < p.ph_end; ++ph) {
        if (ph == 0) ph_init(wv, p, lds);
        else {
            const int layer = (ph - 1) / 7, sub = (ph - 1) % 7;
            if (sub == 0) ph_proj(wv, p, layer, lds);
            else if (sub == 1) { ph_q(wv, p, layer, lds); ph_k(wv, p, layer, lds); ph_v(wv, p, layer, lds); ph_e(wv, p, layer, lds); }
            else if (sub == 2) { ph_scan(wv, p, layer, lds); ph_attn(wv, p, layer, lds); }
            else if (sub == 3) ph_y(wv, p, layer, lds);
            else if (sub == 4) ph_glu(wv, p, layer, lds);
            else if (sub == 5) ph_out(wv, p, layer, lds);
            else ph_row(wv, p, layer, lds);
        }
        if (ph + 1 < p.ph_end && p.coop) {
            if (p.coop > 1) cg::this_grid().sync();
            else xcd_barrier(bar, (volatile LAS unsigned*)&xb_words, lane_id_asm() == 0 && wv == 0, gridDim.x);
        }
    }
}

extern "C" void kernel_launch(void* const* d_in, const int* in_sizes, int n_in, void* d_out, int out_size, void* d_ws, size_t ws_size, hipStream_t stream) {
    constexpr size_t kDynLds = STAGE_BYTES;
    static int grid_blocks = 0;
    if (!grid_blocks) {
        hipFuncSetAttribute((const void*)hymba_megakernel, hipFuncAttributeMaxDynamicSharedMemorySize, (int)kDynLds);
        int dev = 0, cus = 0, per_cu = 0;
        hipGetDevice(&dev);
        hipDeviceGetAttribute(&cus, hipDeviceAttributeMultiprocessorCount, dev);
        hipOccupancyMaxActiveBlocksPerMultiprocessor(&per_cu, hymba_megakernel, 512, kDynLds);
        if (per_cu < 1) per_cu = 1;
        grid_blocks = cus * per_cu; if (grid_blocks > 256) grid_blocks = 256;
    }
    if (ws_size < WS_NEED) { fprintf(stderr, "workspace too small: %zu < %zu\n", ws_size, (size_t)WS_NEED); }
    Params p; memset(&p, 0, sizeof(p));
    p.x = (const float*)d_in[0]; p.pos = (const int*)d_in[1]; p.norm_pre = (const float*)d_in[2]; p.norm_post = (const float*)d_in[3]; p.w_in = (const float*)d_in[4];
    p.q_norm = (const float*)d_in[5]; p.w_uq = (const float*)d_in[6]; p.kv_norm = (const float*)d_in[7]; p.w_ukv = (const float*)d_in[8];
    p.a_re = (const float*)d_in[9]; p.a_im = (const float*)d_in[10]; p.b_re = (const float*)d_in[11]; p.b_im = (const float*)d_in[12]; p.c_re = (const float*)d_in[13]; p.c_im = (const float*)d_in[14];
    p.d_skip = (const float*)d_in[15]; p.log_step = (const float*)d_in[16]; p.w_glu = (const float*)d_in[17]; p.w_out = (const float*)d_in[18];
    p.out = (float*)d_out; p.ws = (unsigned char*)d_ws;
    for (int i = 0; i < 32; ++i) p.inv_freq[i] = (float)std::pow(10000.0, -(double)i / 32.0);
#ifdef MULTI_LAUNCH
    for (int ph = 0; ph < NPHASE; ++ph) { p.ph_begin = ph; p.ph_end = ph + 1; p.coop = 0; hipLaunchKernelGGL(hymba_megakernel, dim3(grid_blocks), dim3(512), kDynLds, stream, p); }
#else
    p.ph_begin = 0; p.ph_end = NPHASE; p.coop = 1;
    (void)hipMemsetAsync((unsigned char*)d_ws + OFF_BAR, 0, BAR_BYTES, stream);
    void* args[] = {&p};
    hipError_t e = hipLaunchCooperativeKernel((void*)hymba_megakernel, dim3(grid_blocks), dim3(512), args, kDynLds, stream);
    if (e != hipSuccess) fprintf(stderr, "cooperative launch failed: %s (grid %d)\n", hipGetErrorString(e), grid_blocks);
#endif
}
```

```cpp
#include <hip/hip_runtime.h>
#include <hip/hip_cooperative_groups.h>
#include <cstdio>
#include <cstring>
#include <cmath>
namespace cg = cooperative_groups;

#define LAS __attribute__((address_space(3)))
typedef unsigned short bf16_t;
typedef short bf16x8 __attribute__((ext_vector_type(8)));
typedef float f32x4 __attribute__((ext_vector_type(4)));
typedef float f32x2 __attribute__((ext_vector_type(2)));
typedef float f32x16 __attribute__((ext_vector_type(16)));
typedef unsigned u32x4 __attribute__((ext_vector_type(4)));
typedef unsigned u32x2 __attribute__((ext_vector_type(2)));

constexpr int SEQ = 16384, DM = 2048, NIN = 4096  , NIN_REAL = 3904, DEPTH = 4;
constexpr int C_CQ = 0, C_CKV = 512, C_KR = 768, C_GM = 832, C_U = 1856, C_GS = 2880;
constexpr int NQ = 1536, NKF = 1536;
constexpr int TCH = 16, NCH = SEQ / TCH  , KCAT = 384;
constexpr float EPS = 1e-6f;

constexpr size_t OFF_XN = 0;
constexpr size_t OFF_MIXED = 0;
constexpr size_t OFF_PROJ = OFF_XN + (size_t)SEQ * DM * 2;
constexpr size_t OFF_UCAT = OFF_PROJ + (size_t)SEQ * NIN * 2;
constexpr size_t OFF_Q = OFF_UCAT + (size_t)64 * NCH * KCAT * 2;
constexpr size_t OFF_YACT = OFF_Q;
constexpr size_t OFF_KF = OFF_Q + (size_t)SEQ * NQ * 2;
constexpr size_t OFF_VT = OFF_KF + (size_t)SEQ * NKF * 2;
constexpr size_t OFF_OUTB = OFF_KF;
constexpr size_t OFF_EBUF = OFF_XN;
constexpr size_t OFF_WIN = OFF_VT + (size_t)1024 * SEQ * 2;
constexpr size_t OFF_WUQ = OFF_WIN + (size_t)NIN * DM * 2;
constexpr size_t OFF_WK = OFF_WUQ + (size_t)1536 * 512 * 2;
constexpr size_t OFF_WV = OFF_WK + (size_t)1024 * 256 * 2;
constexpr size_t OFF_WGLU = OFF_WV + (size_t)1024 * 256 * 2;
constexpr size_t OFF_WOUT = OFF_WGLU + (size_t)2048 * 1024 * 2;
constexpr size_t OFF_BT1 = OFF_WOUT + (size_t)2048 * 2048 * 2;
constexpr size_t BT1_BYTES = (size_t)(64 * 128 + 128) * 256 * 2, BT2_BYTES = (size_t)64 * 256 * KCAT * 2;
constexpr size_t OFF_BT2 = OFF_BT1 + DEPTH * BT1_BYTES;
constexpr size_t OFF_COS = OFF_BT2 + DEPTH * BT2_BYTES;
constexpr size_t OFF_SIN = OFF_COS + (size_t)SEQ * 32 * 4;
constexpr size_t OFF_SS = OFF_SIN + (size_t)SEQ * 32 * 4;
constexpr size_t OFF_BAR = OFF_SS + (size_t)SEQ * 16 * 4;
constexpr size_t BAR_BYTES = 3456 * 4;
constexpr size_t WS_NEED = OFF_BAR + BAR_BYTES;

struct Params {
    const float* x; const int* pos; const float* norm_pre; const float* norm_post; const float* w_in; const float* q_norm; const float* w_uq;
    const float* kv_norm; const float* w_ukv; const float* a_re; const float* a_im; const float* b_re; const float* b_im; const float* c_re;
    const float* c_im; const float* d_skip; const float* log_step; const float* w_glu; const float* w_out;
    float* out; unsigned char* ws; unsigned long long pad0;
    float inv_freq[32];
    int ph_begin, ph_end, coop, pad1;
};

__device__ __forceinline__ unsigned cvt_pk_bf16(float lo, float hi) { unsigned r; asm volatile("v_cvt_pk_bf16_f32 %0, %1, %2" : "=v"(r) : "v"(lo), "v"(hi)); return r; }
__device__ __forceinline__ float bf2f(unsigned short b) { return __uint_as_float(((unsigned)b) << 16); }
__device__ __forceinline__ float bflo(unsigned w) { return __uint_as_float(w << 16); }
__device__ __forceinline__ float bfhi(unsigned w) { return __uint_as_float(w & 0xffff0000u); }
__device__ __forceinline__ u32x4 pack8(f32x4 a, f32x4 b) { u32x4 r; r[0] = cvt_pk_bf16(a[0], a[1]); r[1] = cvt_pk_bf16(a[2], a[3]); r[2] = cvt_pk_bf16(b[0], b[1]); r[3] = cvt_pk_bf16(b[2], b[3]); return r; }
__device__ __forceinline__ size_t erow_off(int R) { return (size_t)(R >> 2) * 1024 + 512 + (size_t)(R & 3) * 128; }
__device__ __forceinline__ float fast_exp2(float x) { return __builtin_amdgcn_exp2f(x); }
__device__ __forceinline__ float fast_rcp(float x) { return __builtin_amdgcn_rcpf(x); }
__device__ __forceinline__ float sigmoidf_(float x) { return fast_rcp(1.0f + fast_exp2(-1.4426950408889634f * x)); }
__device__ __forceinline__ float siluf_(float x) { return x * sigmoidf_(x); }
__device__ __forceinline__ float sig_silu_(float g, float b) { return b * fast_rcp((1.0f + fast_exp2(-1.4426950408889634f * g)) * (1.0f + fast_exp2(-1.4426950408889634f * b))); }
__device__ __forceinline__ float gelu_tanh(float x) {
    const float u = 0.7978845608028654f * (x + 0.044715f * x * x * x);
    return x * sigmoidf_(2.0f * u);
}
__device__ __forceinline__ void sincos_rev_d(double ang, float& s, float& c) {
    double rev = ang * 0.15915494309189533577; rev -= rint(rev);
    const float f = (float)rev; s = __builtin_amdgcn_sinf(f); c = __builtin_amdgcn_cosf(f);
}
__device__ __forceinline__ void sincos_rev(float ang, float& s, float& c) {
    double rev = (double)ang * 0.15915494309189533577; rev -= rint(rev);
    const float f = (float)rev; s = __builtin_amdgcn_sinf(f); c = __builtin_amdgcn_cosf(f);
}

__device__ __forceinline__ int launder_v(int x) { asm volatile("" : "+v"(x)); return x; }
__device__ __forceinline__ int launder_s(int x) { asm volatile("" : "+s"(x)); return x; }
__device__ __forceinline__ int lane_id_asm() { int x; asm volatile("v_mbcnt_lo_u32_b32 %0, -1, 0\n\tv_mbcnt_hi_u32_b32 %0, -1, %0" : "=&v"(x)); return x; }
#define TID() (launder_s(wv) * 64 + lane_id_asm())
#define BID() launder_s((int)blockIdx.x)
#define GDIM() launder_s((int)gridDim.x)
#define LIDS const int tid_l = TID(), bid_l = BID(), gdim_l = GDIM(); (void)tid_l; (void)bid_l; (void)gdim_l;
constexpr int BM = 256, BK = 64, HALF = 128, HTB = HALF * BK * 2, STAGE_BYTES = 8 * HTB, NXCD = 8, WGM = 8;
__device__ __forceinline__ int lds_byte(int r, int c) { const int st = (r >> 4) * 2 + (c >> 5), rr = r & 15, cc = c & 31, ob = rr * 64 + cc * 2; return st * 1024 + (ob ^ (((ob >> 9) & 1) << 5)); }
__device__ __forceinline__ void stage_rc(int b, int& R, int& C) { const int st = b / 1024, sb = b % 1024, swz = sb ^ (((sb >> 9) & 1) << 5); R = (st >> 1) * 16 + swz / 64; C = (st & 1) * 32 + (swz % 64) / 2; }
__device__ __forceinline__ int perm32(int rho) { const int n = rho >> 4, i = rho & 15; return 8 * (i >> 2) + 4 * n + (i & 3); }

struct Unit { int pm, pn; };
struct Gemm { const bf16_t* A; const bf16_t* Bt; int lda, ldb, K; size_t tstepA, tstepB; int amode; };

struct StaticOrder {
    int nM, nN, nwg, G, c;
    __device__ void init(int M, int N, int G_, int c_) { nM = M / BM; nN = N / BM; nwg = nM * nN; G = G_; c = c_; }
    __device__ bool next(int i, Unit& u) const {
        const long L = (long)i * G + c; if (L >= nwg) return false;
        int wgid = (int)L; { const int q = nwg / NXCD, r = nwg % NXCD, xcd = wgid % NXCD, off = wgid / NXCD; wgid = (xcd < r ? xcd * (q + 1) : r * (q + 1) + (xcd - r) * q) + off; }
        const int nig = WGM * nN, gid = wgid / nig, fm = gid * WGM, gsz = (nM - fm) < WGM ? (nM - fm) : WGM;
        u.pm = fm + ((wgid % nig) % gsz); u.pn = (wgid % nig) / gsz; return true;
    }
};
struct GroupOrderE {
    int G, c;
    __device__ bool next(int i, Unit& u) const { int idx; if (G == 256) { if (c < 128 || i >= 2) return false; const int xcd = c & 7, k2 = ((c - 128) >> 3) * 2 + i; idx = (xcd * 8 + (k2 >> 2)) * 4 + (k2 & 3); } else { idx = i * G + ((c + G / 2) % G); if (idx >= 256) return false; }
        u.pm = idx; u.pn = idx >> 2; return true; }
};
struct GroupOrder {
    int G, c;
    __device__ bool next(int i, Unit& u) const { int idx = i * G + c; if (idx >= 256) return false;
        if (G == 256) { const int xcd = c & 7, k = c >> 3; idx = (xcd * 8 + (k >> 2)) * 4 + (k & 3); }
        u.pm = idx; u.pn = idx >> 2; return true; }
};

template <class Epi, class Sched>
__device__ __forceinline__ void gemm_phase(int wv, LAS unsigned char* lds, const Gemm g, const Sched& S, const Epi& E) { LIDS
    const int tid = tid_l, wid = __builtin_amdgcn_readfirstlane(tid >> 6), lane = tid & 63, wr = wid >> 2, wc = wid & 3, fr = lane & 15, fq = lane >> 4;
    const int K = g.K, nt = K / BK;
    unsigned voffA, voffB;
    { int R, C; stage_rc(tid * 16, R, C); const int Rb = (R & ~31) + perm32(R & 31);
      voffA = g.amode ? (unsigned)((C >> 4) * (SEQ * 16) + R * 16 + (C & 15)) * 2u : (unsigned)(R * g.lda + C) * 2u; voffB = (unsigned)(Rb * g.ldb + C) * 2u; }
    const size_t rowA = g.amode ? (size_t)32 : (size_t)g.lda * 2;
    const size_t voffA_q = 64 * rowA, voffB_q = (size_t)64 * g.ldb * 2;
    const size_t kstepA = g.amode ? (size_t)4 * SEQ * 32 : (size_t)(BK * 2), kstepB = (size_t)(BK * 2);
    const size_t hstepA = HALF * rowA, hstepB = (size_t)HALF * g.ldb * 2;
    const unsigned ldsw = (unsigned)wid * 1024u;
    const int aoff = lds_byte(wr * 64 + fr, fq * 8), boff = lds_byte(wc * 32 + fr, fq * 8);
#define PG8_SA(b, h) (((b) * 2 + (h)) * HTB)
#define PG8_SB(b, h) ((4 + (b) * 2 + (h)) * HTB)
#define PG8_STAGE(bufoff, gbase, voff) do { _Pragma("unroll") for (int _i = 0; _i < 2; ++_i) { const char* _gb = (const char*)(gbase) + (size_t)_i * (voff##_q); asm volatile("" : "+s"(_gb)); \
        __builtin_amdgcn_global_load_lds((const unsigned*)(_gb + (voff)), (LAS unsigned*)(lds + (bufoff) + ldsw + _i * 8192), 16, 0, 0); } } while (0)
#define PG8_LDA(dst, b, h) do { _Pragma("unroll") for (int m = 0; m < 4; ++m) _Pragma("unroll") for (int k = 0; k < 2; ++k) dst[m][k] = *(const LAS bf16x8*)(lds + PG8_SA(b, h) + aoff + m * 2048 + k * 1024); } while (0)
#define PG8_LDB(dst, b, h) do { _Pragma("unroll") for (int n = 0; n < 2; ++n) _Pragma("unroll") for (int k = 0; k < 2; ++k) dst[n][k] = *(const LAS bf16x8*)(lds + PG8_SB(b, h) + boff + n * 2048 + k * 1024); } while (0)
#define PG8_MMA(ai, bj, At, Bt) do { __builtin_amdgcn_s_setprio(1); _Pragma("unroll") for (int m = 0; m < 4; ++m) _Pragma("unroll") for (int n = 0; n < 2; ++n) _Pragma("unroll") for (int k = 0; k < 2; ++k) \
        acc[ai][bj][m][n] = __builtin_amdgcn_mfma_f32_16x16x32_bf16(Bt[n][k], At[m][k], acc[ai][bj][m][n], 0, 0, 0); __builtin_amdgcn_s_setprio(0); } while (0)
#define PG8_WAIT_V(n) asm volatile("s_waitcnt vmcnt(" #n ")" ::: "memory")
#define PG8_WAIT_L(n) asm volatile("s_waitcnt lgkmcnt(" #n ")" ::: "memory")
#define PG8_BAR __builtin_amdgcn_s_barrier()
#define PG8_SCHED __builtin_amdgcn_sched_barrier(0)
    Unit cur, nxt; int ui = 0;
    if (!S.next(0, cur)) return;
    float zf = 0.f; asm volatile("" : "+v"(zf)); const f32x4 zero4 = (f32x4){zf, zf, zf, zf};
    f32x4 acc[2][2][4][2];
#pragma unroll
    for (int a = 0; a < 2; ++a)
#pragma unroll
        for (int b = 0; b < 2; ++b)
#pragma unroll
            for (int m = 0; m < 4; ++m)
#pragma unroll
                for (int n = 0; n < 2; ++n) acc[a][b][m][n] = zero4;
    bf16x8 At[4][2], B0[2][2], B1[2][2];
    const char* cA = (const char*)g.A + (size_t)cur.pm * g.tstepA; const char* cB = (const char*)g.Bt + (size_t)cur.pn * g.tstepB;
    PG8_STAGE(PG8_SB(0, 0), cB, voffB); PG8_STAGE(PG8_SA(0, 0), cA, voffA); PG8_STAGE(PG8_SB(0, 1), cB + hstepB, voffB); PG8_STAGE(PG8_SA(0, 1), cA + hstepA, voffA);
    if (wr == 1) PG8_BAR;
    PG8_WAIT_V(4); PG8_BAR;
    PG8_STAGE(PG8_SB(1, 0), cB + kstepB, voffB); PG8_STAGE(PG8_SA(1, 0), cA + kstepA, voffA); PG8_STAGE(PG8_SB(1, 1), cB + hstepB + kstepB, voffB);
    PG8_WAIT_V(6); PG8_BAR;
    for (;;) {
        const bool has_next = S.next(ui + 1, nxt);
        const char* nA = has_next ? (const char*)g.A + (size_t)nxt.pm * g.tstepA : cA; const char* nB = has_next ? (const char*)g.Bt + (size_t)nxt.pn * g.tstepB : cB;
        for (int t = 0; t < nt; t += 2) {
            const bool last = (t == nt - 2);
            const char* a1 = cA + (size_t)(t + 1) * kstepA;
            const char* a2 = last ? nA : cA + (size_t)(t + 2) * kstepA; const char* b2 = last ? nB : cB + (size_t)(t + 2) * kstepB;
            const char* a3 = a2 + kstepA; const char* b3 = b2 + kstepB;
            asm volatile("" : "+s"(a1), "+s"(a2), "+s"(b2), "+s"(a3), "+s"(b3));
            PG8_LDB(B0, 0, 0); PG8_SCHED; PG8_LDA(At, 0, 0); PG8_STAGE(PG8_SA(1, 1), a1 + hstepA, voffA);
            PG8_WAIT_L(8); PG8_BAR; PG8_WAIT_L(0); PG8_MMA(0, 0, At, B0); PG8_BAR; PG8_SCHED;
            PG8_LDB(B1, 0, 1); PG8_STAGE(PG8_SB(0, 0), b2, voffB);
            PG8_BAR; PG8_WAIT_L(0); PG8_MMA(0, 1, At, B1); PG8_BAR;
            PG8_LDA(At, 0, 1); PG8_STAGE(PG8_SA(0, 0), a2, voffA);
            PG8_BAR; PG8_WAIT_L(0); PG8_MMA(1, 0, At, B0); PG8_BAR; PG8_SCHED;
            PG8_STAGE(PG8_SB(0, 1), b2 + hstepB, voffB);
            PG8_WAIT_V(6); PG8_BAR; PG8_MMA(1, 1, At, B1); PG8_BAR;
            PG8_LDB(B0, 1, 0); PG8_SCHED; PG8_LDA(At, 1, 0); PG8_STAGE(PG8_SA(0, 1), a2 + hstepA, voffA);
            PG8_WAIT_L(8); PG8_BAR; PG8_WAIT_L(0); PG8_MMA(0, 0, At, B0); PG8_BAR; PG8_SCHED;
            PG8_LDB(B1, 1, 1); PG8_STAGE(PG8_SB(1, 0), b3, voffB);
            PG8_BAR; PG8_WAIT_L(0); PG8_MMA(0, 1, At, B1); PG8_BAR;
            PG8_LDA(At, 1, 1); PG8_STAGE(PG8_SA(1, 0), a3, voffA);
            PG8_BAR; PG8_WAIT_L(0); PG8_MMA(1, 0, At, B0); PG8_BAR; PG8_SCHED;
            PG8_STAGE(PG8_SB(1, 1), b3 + hstepB, voffB);
            PG8_WAIT_V(6); PG8_BAR; PG8_MMA(1, 1, At, B1); PG8_BAR;
        }
        { const int l2 = lane_id_asm(); E(acc, cur, wr, wc, l2 & 15, l2 >> 4); }
        if (!has_next) break;
#pragma unroll
        for (int a = 0; a < 2; ++a)
#pragma unroll
            for (int b = 0; b < 2; ++b)
#pragma unroll
                for (int m = 0; m < 4; ++m)
#pragma unroll
                    for (int n = 0; n < 2; ++n) acc[a][b][m][n] = zero4;
        cur = nxt; cA = nA; cB = nB; ++ui;
    }
    PG8_WAIT_V(0);
    if (wr == 0) PG8_BAR;
    PG8_BAR;
#undef PG8_SA
#undef PG8_SB
#undef PG8_STAGE
#undef PG8_LDA
#undef PG8_LDB
#undef PG8_MMA
#undef PG8_WAIT_V
#undef PG8_WAIT_L
#undef PG8_BAR
#undef PG8_SCHED
}

typedef f32x4 AccT[2][2][4][2];
#define EPI_ROWS(u) const int row0 = (u).pm * BM + wr * 64 + fr; const int colbase = (u).pn * BM + wc * 32 + 8 * fq;

struct EpiProj {
    bf16_t* proj; bf16_t* ucat; float* ssp;
    __device__ __forceinline__ void operator()(const AccT& acc, const Unit& u, int wr, int wc, int fr, int fq) const {
        EPI_ROWS(u)
        const bool do_ss = (u.pn <= 2);
#pragma unroll
        for (int ai = 0; ai < 2; ++ai)
#pragma unroll
            for (int m = 0; m < 4; ++m) {
                const int row = row0 + ai * HALF + m * 16; float ss = 0.f;
#pragma unroll
                for (int bj = 0; bj < 2; ++bj) {
                    const int col = colbase + bj * HALF; const f32x4 v0 = acc[ai][bj][m][0], v1 = acc[ai][bj][m][1];
                    const u32x4 pk = pack8(v0, v1);
                    if (col >= C_U && col < C_GS) { const int ch = col - C_U, gg = ch >> 4, hh = ch & 15;
                        *(u32x4*)(ucat + ((size_t)(gg * NCH + (row >> 4)) * KCAT + (row & 15) * 16 + hh)) = pk; }
                    else if (col < NIN_REAL) *(u32x4*)(proj + (size_t)row * NIN + col) = pk;
                    if (do_ss) ss += v0[0] * v0[0] + v0[1] * v0[1] + v0[2] * v0[2] + v0[3] * v0[3] + v1[0] * v1[0] + v1[1] * v1[1] + v1[2] * v1[2] + v1[3] * v1[3];
                }
                __builtin_amdgcn_sched_barrier(0);
                if (do_ss) { ss += __shfl_xor(ss, 16); ss += __shfl_xor(ss, 32); if (fq == 0) ssp[(size_t)row * 16 + u.pn * 4 + wc] = ss; }
            }
    }
};
struct EpiQ {
    bf16_t* Q; const float* ssp; const float* cosT; const float* sinT;
    __device__ __forceinline__ void operator()(const AccT& acc, const Unit& u, int wr, int wc, int fr, int fq) const {
        EPI_ROWS(u)
#pragma unroll
        for (int ai = 0; ai < 2; ++ai)
#pragma unroll
            for (int m = 0; m < 4; ++m) {
                const int row = row0 + ai * HALF + m * 16;
                const f32x4 pa = *(const f32x4*)(ssp + (size_t)row * 16), pb = *(const f32x4*)(ssp + (size_t)row * 16 + 4);
                const float ssr = ((pa[0] + pa[1]) + (pa[2] + pa[3])) + ((pb[0] + pb[1]) + (pb[2] + pb[3]));
                const float sc = rsqrtf(ssr * (1.0f / 512.0f) + EPS) * (1.4426950408889634f * 0.07216878364870322f);
#pragma unroll
                for (int bj = 0; bj < 2; ++bj) {
                    const int col = colbase + bj * HALF; f32x4 v0 = acc[ai][bj][m][0], v1 = acc[ai][bj][m][1];
                    const int d = col % 192;
                    if (d >= 128) { const int i0 = (d - 128) >> 1;
                        const f32x4 c4 = *(const f32x4*)(cosT + (size_t)row * 32 + i0), s4 = *(const f32x4*)(sinT + (size_t)row * 32 + i0);
                        f32x4 o0, o1;
                        o0[0] = v0[0] * c4[0] - v0[1] * s4[0]; o0[1] = v0[1] * c4[0] + v0[0] * s4[0];
                        o0[2] = v0[2] * c4[1] - v0[3] * s4[1]; o0[3] = v0[3] * c4[1] + v0[2] * s4[1];
                        o1[0] = v1[0] * c4[2] - v1[1] * s4[2]; o1[1] = v1[1] * c4[2] + v1[0] * s4[2];
                        o1[2] = v1[2] * c4[3] - v1[3] * s4[3]; o1[3] = v1[3] * c4[3] + v1[2] * s4[3];
                        v0 = o0; v1 = o1; }
                    *(u32x4*)(Q + (size_t)row * NQ + col) = pack8(v0 * sc, v1 * sc); __builtin_amdgcn_sched_barrier(0);
                }
            }
    }
};
struct EpiK {
    bf16_t* Kf; const float* ssp;
    __device__ __forceinline__ void operator()(const AccT& acc, const Unit& u, int wr, int wc, int fr, int fq) const {
        EPI_ROWS(u)
#pragma unroll
        for (int ai = 0; ai < 2; ++ai)
#pragma unroll
            for (int m = 0; m < 4; ++m) {
                const int row = row0 + ai * HALF + m * 16;
                const f32x4 pc = *(const f32x4*)(ssp + (size_t)row * 16 + 8);
                const float sc = rsqrtf(((pc[0] + pc[1]) + (pc[2] + pc[3])) * (1.0f / 256.0f) + EPS);
#pragma unroll
                for (int bj = 0; bj < 2; ++bj) {
                    const int col = colbase + bj * HALF, head = col >> 7, d = col & 127;
                    *(u32x4*)(Kf + (size_t)row * NKF + head * 192 + d) = pack8(acc[ai][bj][m][0] * sc, acc[ai][bj][m][1] * sc);
                }
            }
    }
};
struct EpiVt {
    bf16_t* Vt; const float* ssp;
    __device__ __forceinline__ void operator()(const AccT& acc, const Unit& u, int wr, int wc, int fr, int fq) const {
        EPI_ROWS(u)
#pragma unroll
        for (int bj = 0; bj < 2; ++bj) {
            const int col = colbase + bj * HALF;
            f32x4 s0, s1;
#pragma unroll
            for (int j = 0; j < 4; ++j) { const f32x4 pc = *(const f32x4*)(ssp + (size_t)(col + j) * 16 + 8), pd = *(const f32x4*)(ssp + (size_t)(col + 4 + j) * 16 + 8);
                s0[j] = rsqrtf(((pc[0] + pc[1]) + (pc[2] + pc[3])) * (1.0f / 256.0f) + EPS); s1[j] = rsqrtf(((pd[0] + pd[1]) + (pd[2] + pd[3])) * (1.0f / 256.0f) + EPS); }
#pragma unroll
            for (int ai = 0; ai < 2; ++ai)
#pragma unroll
                for (int m = 0; m < 4; ++m) {
                    const int row = row0 + ai * HALF + m * 16;
                    *(u32x4*)(Vt + (size_t)row * SEQ + col) = pack8(acc[ai][bj][m][0] * s0, acc[ai][bj][m][1] * s1);
                }
        }
    }
};
struct EpiE {
    float* Ebuf;
    __device__ __forceinline__ void operator()(const AccT& acc, const Unit& u, int wr, int wc, int fr, int fq) const {
        const int row0 = u.pm * BM + wr * 64 + fr, cc = wc * 32 + 8 * fq;
#pragma unroll
        for (int ai = 0; ai < 2; ++ai)
#pragma unroll
            for (int m = 0; m < 4; ++m) {
                const int row = row0 + ai * HALF + m * 16;
                *(f32x4*)(Ebuf + erow_off(row) + cc) = acc[ai][0][m][0]; *(f32x4*)(Ebuf + erow_off(row) + cc + 4) = acc[ai][0][m][1];
            }
    }
};
struct EpiY {
    bf16_t* Yact; const bf16_t* ucat; const float* dskip;
    __device__ __forceinline__ void operator()(const AccT& acc, const Unit& u, int wr, int wc, int fr, int fq) const {
        const int row0 = u.pm * BM + wr * 64 + fr, g = u.pn;
#pragma unroll
        for (int bj = 0; bj < 2; ++bj) {
            const int n = bj * HALF + wc * 32 + 8 * fq, t = n >> 4, hh = n & 15;
            const f32x4 d0 = *(const f32x4*)(dskip + g * 16 + hh), d1 = *(const f32x4*)(dskip + g * 16 + hh + 4);
            u32x4 uv[8];
#pragma unroll
            for (int rr = 0; rr < 8; ++rr) uv[rr] = *(const u32x4*)(ucat + (size_t)(row0 + (rr >> 2) * HALF + (rr & 3) * 16) * KCAT + n);
            __builtin_amdgcn_sched_barrier(0);
#pragma unroll
            for (int ai = 0; ai < 2; ++ai)
#pragma unroll
                for (int m = 0; m < 4; ++m) {
                    const int R = row0 + ai * HALF + m * 16;
                    const u32x4 uu = uv[ai * 4 + m];
                    f32x4 y0 = acc[ai][bj][m][0], y1 = acc[ai][bj][m][1];
                    y0[0] += d0[0] * bflo(uu[0]); y0[1] += d0[1] * bfhi(uu[0]); y0[2] += d0[2] * bflo(uu[1]); y0[3] += d0[3] * bfhi(uu[1]);
                    y1[0] += d1[0] * bflo(uu[2]); y1[1] += d1[1] * bfhi(uu[2]); y1[2] += d1[2] * bflo(uu[3]); y1[3] += d1[3] * bfhi(uu[3]);
#pragma unroll
                    for (int j = 0; j < 4; ++j) { y0[j] = gelu_tanh(y0[j]); y1[j] = gelu_tanh(y1[j]); }
                    *(u32x4*)(Yact + (size_t)R * 256 + n) = pack8(y0, y1); __builtin_amdgcn_sched_barrier(0);
                }
        }
    }
};
struct EpiGlu {
    bf16_t* mixed; const bf16_t* proj;
    __device__ __forceinline__ void operator()(const AccT& acc, const Unit& u, int wr, int wc, int fr, int fq) const {
        const int row0 = u.pm * BM + wr * 64 + fr, ch = u.pn * 128 + wc * 32 + 8 * fq;
        u32x4 gsv[8];
#pragma unroll
        for (int rr = 0; rr < 8; ++rr) gsv[rr] = *(const u32x4*)(proj + (size_t)(row0 + (rr >> 2) * HALF + (rr & 3) * 16) * NIN + C_GS + ch);
        __builtin_amdgcn_sched_barrier(0);
#pragma unroll
        for (int ai = 0; ai < 2; ++ai)
#pragma unroll
            for (int m = 0; m < 4; ++m) {
                const int row = row0 + ai * HALF + m * 16;
#pragma unroll
                for (int n = 0; n < 2; ++n) {
                    const unsigned g_lo = gsv[ai * 4 + m][2 * n], g_hi = gsv[ai * 4 + m][2 * n + 1];
                    const f32x4 a0 = acc[ai][0][m][n], g0 = acc[ai][1][m][n];
                    const float o0 = a0[0] * sig_silu_(g0[0], bflo(g_lo)), o1 = a0[1] * sig_silu_(g0[1], bfhi(g_lo));
                    const float o2 = a0[2] * sig_silu_(g0[2], bflo(g_hi)), o3 = a0[3] * sig_silu_(g0[3], bfhi(g_hi));
                    u32x2 w; w[0] = cvt_pk_bf16(o0, o1); w[1] = cvt_pk_bf16(o2, o3);
                    *(u32x2*)(mixed + (size_t)row * DM + 1024 + ch + 4 * n) = w;
                    __builtin_amdgcn_sched_barrier(0);
                }
            }
    }
};
struct EpiOut {
    bf16_t* outb;
    __device__ __forceinline__ void operator()(const AccT& acc, const Unit& u, int wr, int wc, int fr, int fq) const {
        EPI_ROWS(u)
#pragma unroll
        for (int ai = 0; ai < 2; ++ai)
#pragma unroll
            for (int m = 0; m < 4; ++m) {
                const int row = row0 + ai * HALF + m * 16;
#pragma unroll
                for (int bj = 0; bj < 2; ++bj) *(u32x4*)(outb + (size_t)row * DM + colbase + bj * HALF) = pack8(acc[ai][bj][m][0], acc[ai][bj][m][1]);
            }
    }
};

__device__ __forceinline__ float wave_sum(float v) {
#pragma unroll
    for (int o = 32; o >= 1; o >>= 1) v += __shfl_xor(v, o);
    return v;
}
__device__ __forceinline__ void rowpass(int wv, const float* xin, const bf16_t* outb, const float* g_post, const float* g_pre_next, float* xres, bf16_t* xn, int mode) { LIDS
    const int lane = tid_l & 63, wid = tid_l >> 6;
#define RP_OFF(i) (((i) >> 1) * 512 + lane * 8 + ((i) & 1) * 4)
    for (int row = bid_l * 8 + wid; row < SEQ; row += gdim_l * 8) {
        f32x4 xv[8]; float ss = 0.f;
        if (mode == 0) {
#pragma unroll
            for (int i = 0; i < 8; ++i) xv[i] = __builtin_nontemporal_load((const f32x4*)(xin + (size_t)row * DM + RP_OFF(i)));
        } else {
            f32x4 ov[8]; float so = 0.f;
#pragma unroll
            for (int ip = 0; ip < 4; ++ip) { const u32x4 w = __builtin_nontemporal_load((const u32x4*)(outb + (size_t)row * DM + ip * 512 + lane * 8));
                ov[2 * ip][0] = bflo(w[0]); ov[2 * ip][1] = bfhi(w[0]); ov[2 * ip][2] = bflo(w[1]); ov[2 * ip][3] = bfhi(w[1]);
                ov[2 * ip + 1][0] = bflo(w[2]); ov[2 * ip + 1][1] = bfhi(w[2]); ov[2 * ip + 1][2] = bflo(w[3]); ov[2 * ip + 1][3] = bfhi(w[3]); }
#pragma unroll
            for (int i = 0; i < 8; ++i) so += ov[i][0] * ov[i][0] + ov[i][1] * ov[i][1] + ov[i][2] * ov[i][2] + ov[i][3] * ov[i][3];
            so = wave_sum(so); const float inv = rsqrtf(so * (1.0f / DM) + EPS);
#pragma unroll
            for (int i = 0; i < 8; ++i) { const f32x4 xo = __builtin_nontemporal_load((const f32x4*)(xin + (size_t)row * DM + RP_OFF(i))); const f32x4 gp = *(const f32x4*)(g_post + RP_OFF(i));
                xv[i] = xo + ov[i] * inv * gp; }
        }
#pragma unroll
        for (int i = 0; i < 8; ++i) { if (mode != 0) __builtin_nontemporal_store(xv[i], (f32x4*)(xres + (size_t)row * DM + RP_OFF(i)));
            ss += xv[i][0] * xv[i][0] + xv[i][1] * xv[i][1] + xv[i][2] * xv[i][2] + xv[i][3] * xv[i][3]; }
        if (g_pre_next) {
            ss = wave_sum(ss); const float inv = rsqrtf(ss * (1.0f / DM) + EPS);
#pragma unroll
            for (int ip = 0; ip < 4; ++ip) { const f32x4 g0 = *(const f32x4*)(g_pre_next + RP_OFF(2 * ip)), g1 = *(const f32x4*)(g_pre_next + RP_OFF(2 * ip + 1));
                const f32x4 y0 = xv[2 * ip] * inv * g0, y1 = xv[2 * ip + 1] * inv * g1;
                *(u32x4*)(xn + (size_t)row * DM + ip * 512 + lane * 8) = pack8(y0, y1); }
        }
    }
#undef RP_OFF
}

template <int MAP> __device__ __forceinline__ int wmap(int n) {
    if (MAP == 0) return n < NIN_REAL ? n : -1;
    if (MAP == 1) { const int head = n / 192, d = n % 192; if (d < 128) return n; const int e = d - 128; return head * 192 + 128 + (e & 1) * 32 + (e >> 1); }
    if (MAP == 2) return (n >> 7) * 256 + (n & 127);
    if (MAP == 3) return (n >> 7) * 256 + 128 + (n & 127);
    if (MAP == 4) { const int pn = n >> 8, r = n & 255; return r < 128 ? pn * 128 + r : 1024 + pn * 128 + (r - 128); }
    return n;
}
template <int MAP> __device__ __forceinline__ void transpose_tile(int wv, const float* src, int ldsrc, int K, const float* gain, bf16_t* dst, int tile, int ktiles, LAS float* tl) { LIDS
    const int n0 = (tile / ktiles) * 64, k0 = (tile % ktiles) * 256, tx = tid_l & 63, ty = tid_l >> 6;
    const int sc = wmap<MAP>(n0 + tx);
    float v[32];
#pragma unroll
    for (int i = 0; i < 32; ++i) { const int k = k0 + ty + 8 * i; v[i] = (sc >= 0) ? __builtin_nontemporal_load(src + (size_t)k * ldsrc + sc) : 0.f; }
    if (gain) {
#pragma unroll
        for (int i = 0; i < 32; ++i) v[i] *= gain[k0 + ty + 8 * i];
    }
#pragma unroll
    for (int i = 0; i < 32; ++i) tl[(ty + 8 * i) * 65 + tx] = v[i];
    __syncthreads();
    {
        const int r = tid_l >> 3;
#pragma unroll
        for (int q = 0; q < 4; ++q) { const int kq = (tid_l & 7) * 8 + 64 * q; f32x4 a, b;
#pragma unroll
            for (int jj = 0; jj < 4; ++jj) { a[jj] = tl[(kq + jj) * 65 + r]; b[jj] = tl[(kq + 4 + jj) * 65 + r]; }
            *(u32x4*)(dst + (size_t)(n0 + r) * K + k0 + kq) = pack8(a, b); }
    }
    __syncthreads();
}
__device__ __forceinline__ void prep_s5_group(int wv, const Params& p, int layer, int g, bf16_t* bt1, bf16_t* bt2, LAS float* L) { LIDS
    LAS float* apr = L; LAS float* api = apr + 17 * 64; LAS float* bbr = api + 17 * 64; LAS float* bbi = bbr + 1024; LAS float* cr = bbi + 1024; LAS float* ci = cr + 1024; LAS float* kt = ci + 1024;
    const int tid = tid_l; const size_t gp = (size_t)layer * 64 + g;
    const float step = expf(p.log_step[gp]);
    for (int i = tid; i < 17 * 64; i += 512) { const int d = i >> 6, pp = i & 63; const float are = p.a_re[gp * 64 + pp], aim = p.a_im[gp * 64 + pp];
        const float mag = expf((float)d * step * are); float s, c; sincos_rev_d((double)d * (double)step * (double)aim, s, c); apr[i] = mag * c; api[i] = mag * s; }
    for (int i = tid; i < 1024; i += 512) { const int hh = i >> 6, pp = i & 63; cr[i] = p.c_re[(gp * 16 + hh) * 64 + pp]; ci[i] = p.c_im[(gp * 16 + hh) * 64 + pp]; }
    __syncthreads();
    for (int i = tid; i < 1024; i += 512) { const int pp = i >> 4; const float are = p.a_re[gp * 64 + pp], aim = p.a_im[gp * 64 + pp];
        const float xr = apr[64 + pp] - 1.0f, xi = api[64 + pp], den = 1.0f / (are * are + aim * aim);
        const float qr = (xr * are + xi * aim) * den, qi = (xi * are - xr * aim) * den;
        const float br = p.b_re[gp * 1024 + i], bi = p.b_im[gp * 1024 + i];
        bbr[i] = qr * br - qi * bi; bbi[i] = qr * bi + qi * br; }
    __syncthreads();
    {
        const int i0 = tid * 8, d = i0 >> 8, hh = (i0 >> 4) & 15, h20 = i0 & 15; float acc8[8];
#pragma unroll
        for (int e = 0; e < 8; ++e) acc8[e] = 0.f;
        for (int pp = 0; pp < 64; ++pp) { const float wr_ = cr[hh * 64 + pp] * apr[d * 64 + pp] - ci[hh * 64 + pp] * api[d * 64 + pp], wi_ = cr[hh * 64 + pp] * api[d * 64 + pp] + ci[hh * 64 + pp] * apr[d * 64 + pp];
#pragma unroll
            for (int e = 0; e < 8; ++e) acc8[e] += wr_ * bbr[pp * 16 + h20 + e] - wi_ * bbi[pp * 16 + h20 + e]; }
#pragma unroll
        for (int e = 0; e < 8; ++e) kt[i0 + e] = acc8[e]; }
    __syncthreads();
    for (int i = tid; i < 256 * KCAT; i += 512) { const int n = i / KCAT, k = i % KCAT, t = n >> 4, hh = n & 15; float v;
        if (k < 256) { const int s = k >> 4, h2 = k & 15; v = (s <= t) ? kt[((t - s) * 16 + hh) * 16 + h2] : 0.f; }
        else { const int pp = (k - 256) >> 1, ri = k & 1, d = t + 1; const float fr_ = cr[hh * 64 + pp] * apr[d * 64 + pp] - ci[hh * 64 + pp] * api[d * 64 + pp], fi_ = cr[hh * 64 + pp] * api[d * 64 + pp] + ci[hh * 64 + pp] * apr[d * 64 + pp];
            v = ri ? -fi_ : fr_; }
        bt2[(size_t)g * 256 * KCAT + i] = (bf16_t)(cvt_pk_bf16(v, 0.f) & 0xffffu); }
    for (int i = tid; i < 128 * 256; i += 512) { const int n = i >> 8, k = i & 255, pp = n >> 1, ri = n & 1, t = k >> 4, hh = k & 15, d = 15 - t;
        const float er = apr[d * 64 + pp] * bbr[pp * 16 + hh] - api[d * 64 + pp] * bbi[pp * 16 + hh], ei = apr[d * 64 + pp] * bbi[pp * 16 + hh] + api[d * 64 + pp] * bbr[pp * 16 + hh];
        bt1[(size_t)g * 128 * 256 + i] = (bf16_t)(cvt_pk_bf16(ri ? ei : er, 0.f) & 0xffffu); }
    __syncthreads();
}
__device__ __forceinline__ void prep_layer(int wv, const Params& p, int layer, LAS unsigned char* lds) { LIDS
    unsigned char* ws = p.ws; LAS float* tl = (LAS float*)lds;
    const float* w_in = p.w_in + (size_t)layer * DM * NIN_REAL; const float* w_uq = p.w_uq + (size_t)layer * 512 * 1536; const float* w_ukv = p.w_ukv + (size_t)layer * 256 * 2048;
    const float* w_glu = p.w_glu + (size_t)layer * 1024 * 2048; const float* w_out = p.w_out + (size_t)layer * 2048 * 2048;
    const float* g_pre = nullptr;
    const float* g_q = p.q_norm + layer * 512; const float* g_kv = p.kv_norm + layer * 256;
    for (int t = bid_l; t < 976; t += gdim_l) {
        if (t < 512) transpose_tile<0>(wv, w_in, NIN_REAL, DM, g_pre, (bf16_t*)(ws + OFF_WIN), t, 8, tl);
        else if (t < 560) transpose_tile<1>(wv, w_uq, 1536, 512, g_q, (bf16_t*)(ws + OFF_WUQ), t - 512, 2, tl);
        else if (t < 576) transpose_tile<2>(wv, w_ukv, 2048, 256, g_kv, (bf16_t*)(ws + OFF_WK), t - 560, 1, tl);
        else if (t < 592) transpose_tile<3>(wv, w_ukv, 2048, 256, g_kv, (bf16_t*)(ws + OFF_WV), t - 576, 1, tl);
        else if (t < 720) transpose_tile<4>(wv, w_glu, 2048, 1024, nullptr, (bf16_t*)(ws + OFF_WGLU), t - 592, 4, tl);
        else transpose_tile<5>(wv, w_out, 2048, 2048, nullptr, (bf16_t*)(ws + OFF_WOUT), t - 720, 8, tl);
    }
}
__device__ __forceinline__ void prep_s5_all(int wv, const Params& p, LAS unsigned char* lds) { LIDS
    unsigned char* ws = p.ws; LAS float* tl = (LAS float*)lds;
    for (int it = gdim_l - 1 - bid_l; it < DEPTH * 64; it += gdim_l) if (it >= 0) { const int layer = it >> 6, g = it & 63;
        prep_s5_group(wv, p, layer, g, (bf16_t*)(ws + OFF_BT1 + layer * BT1_BYTES), (bf16_t*)(ws + OFF_BT2 + layer * BT2_BYTES), tl); }
    unsigned zu = 0u; asm volatile("" : "+v"(zu));
    for (int i = bid_l * 512 + tid_l; i < DEPTH * 128 * 256 / 8; i += gdim_l * 512) { const int layer = i / (128 * 256 / 8), k = i % (128 * 256 / 8);
        *(u32x4*)(ws + OFF_BT1 + layer * BT1_BYTES + (size_t)64 * 128 * 256 * 2 + (size_t)k * 16) = (u32x4){zu, zu, zu, zu}; }
}

__device__ __forceinline__ void krope_pass(int wv, const bf16_t* proj, const float* cosT, const float* sinT, bf16_t* Kf) { LIDS
    for (int idx = bid_l * 512 + tid_l; idx < SEQ * 8; idx += gdim_l * 512) {
        const int l = idx >> 3, i0 = (idx & 7) * 4;
        const u32x2 a = *(const u32x2*)(proj + (size_t)l * NIN + C_KR + i0), b = *(const u32x2*)(proj + (size_t)l * NIN + C_KR + 32 + i0);
        const f32x4 c = *(const f32x4*)(cosT + (size_t)l * 32 + i0), sn = *(const f32x4*)(sinT + (size_t)l * 32 + i0);
        const float x1[4] = {bflo(a[0]), bfhi(a[0]), bflo(a[1]), bfhi(a[1])}, x2[4] = {bflo(b[0]), bfhi(b[0]), bflo(b[1]), bfhi(b[1])};
        u32x4 w;
#pragma unroll
        for (int k = 0; k < 4; ++k) w[k] = cvt_pk_bf16(x1[k] * c[k] - x2[k] * sn[k], x2[k] * c[k] + x1[k] * sn[k]);
#pragma unroll
        for (int h = 0; h < 8; ++h) *(u32x4*)(Kf + (size_t)l * NKF + h * 192 + 128 + 2 * i0) = w;
    }
}

__device__ __forceinline__ void s5_scan(int wv, const Params& p, int layer, const float* Ebuf, bf16_t* ucat, LAS unsigned char* lds) { LIDS
    LAS float* sfin = (LAS float*)lds;
    const int tid = tid_l, chl = tid & 15, seg = tid >> 4;
    for (int it = bid_l; it < 256; it += gdim_l) {
        const int g = it >> 2, pp = (it & 3) * 16 + chl; const size_t gp = (size_t)layer * 64 + g;
        const float step = expf(p.log_step[gp]), are = p.a_re[gp * 64 + pp], aim = p.a_im[gp * 64 + pp];
        float s1, c1; sincos_rev_d(16.0 * (double)step * (double)aim, s1, c1); const float m1 = expf(16.0f * step * are); const float tr = m1 * c1, ti = m1 * s1;
        float s2, c2; sincos_rev_d(512.0 * (double)step * (double)aim, s2, c2); const float m2 = expf(512.0f * step * are); const float wr_ = m2 * c2, wi_ = m2 * s2;
        f32x2 e[32];
        const int R0 = g * NCH + seg * 32;
#pragma unroll
        for (int j = 0; j < 32; ++j) e[j] = *(const f32x2*)(Ebuf + erow_off(R0 + j) + 2 * pp);
        float sr = 0.f, si = 0.f;
#pragma unroll
        for (int j = 0; j < 32; ++j) { const float nr = tr * sr - ti * si + e[j][0], ni = tr * si + ti * sr + e[j][1]; sr = nr; si = ni; }
        __syncthreads();
        sfin[(seg * 16 + chl) * 2] = sr; sfin[(seg * 16 + chl) * 2 + 1] = si;
        __syncthreads();
        float cr_ = 0.f, ci_ = 0.f;
        for (int s = 0; s < seg; ++s) { const float fr_ = sfin[(s * 16 + chl) * 2], fi_ = sfin[(s * 16 + chl) * 2 + 1];
            const float nr = wr_ * cr_ - wi_ * ci_ + fr_, ni = wr_ * ci_ + wi_ * cr_ + fi_; cr_ = nr; ci_ = ni; }
        bf16_t* ub = ucat + ((size_t)g * NCH + seg * 32) * KCAT + 256 + 2 * pp;
#pragma unroll
        for (int j = 0; j < 32; ++j) { *(unsigned*)(ub + (size_t)j * KCAT) = cvt_pk_bf16(cr_, ci_);
            const float nr = tr * cr_ - ti * ci_ + e[j][0], ni = tr * ci_ + ti * cr_ + e[j][1]; cr_ = nr; ci_ = ni; }
    }
}

#define DSR(dst, addr, off) asm volatile("ds_read_b128 %0, %1 offset:%2" : "=v"(dst) : "v"(addr), "n"(off))
#define LGK(n, f) asm volatile("s_waitcnt lgkmcnt(%1)" : "+v"(f) : "n"(n))
constexpr int ATT_KB = 64 * 384, ATT_VB = 128 * 128, ATT_STAGE = ATT_KB + ATT_VB;
__device__ __forceinline__ void attn_phase(int wv, const bf16_t* Q, const bf16_t* Kf, const bf16_t* Vt, const bf16_t* proj, bf16_t* mixed, LAS unsigned char* lds) { LIDS
    const int tid = tid_l, wid = __builtin_amdgcn_readfirstlane(tid >> 6), lane = tid & 63, r = lane & 31, h = lane >> 5;
    unsigned koff[3], voff[2];
#pragma unroll
    for (int i = 0; i < 3; ++i) { const int j = tid + 512 * i, row = j / 24, cc = (j % 24) ^ ((row >> 1) & 7); koff[i] = (unsigned)(row * (NKF * 2) + cc * 16); }
#pragma unroll
    for (int i = 0; i < 2; ++i) { const int j = tid + 512 * i, dv = j >> 3, cc = (j & 7) ^ ((dv >> 1) & 7); voff[i] = (unsigned)dv * (unsigned)(SEQ * 2) + (unsigned)(cc * 16); }
    const int pr = (r & ~12) | ((r & 4) << 1) | ((r & 8) >> 1);
    const int kx = (pr >> 1) & 7, kxs = kx >> 1, kx0 = kx & 1;
    int koffl[4], voffl[4];
#pragma unroll
    for (int kl = 0; kl < 4; ++kl) koffl[kl] = pr * 384 + 32 * (kl ^ kxs) + 16 * (h ^ kx0);
    const int vy = (r >> 1) & 7;
#pragma unroll
    for (int c = 0; c < 4; ++c) voffl[c] = r * 128 + 16 * (((c << 1) | h) ^ vy);
    const unsigned ldsw = (unsigned)wid * 1024u;
#define ATT_ISSUE(t, b) do { const char* _kp = kbase + (size_t)(t) * (64 * NKF * 2); const char* _vp = vbase + (size_t)(t) * 128; asm volatile("" : "+s"(_kp), "+s"(_vp)); \
        _Pragma("unroll") for (int _i = 0; _i < 3; ++_i) __builtin_amdgcn_global_load_lds((const unsigned*)(_kp + koff[_i]), (LAS unsigned*)(lds + (b) * ATT_STAGE + ldsw + _i * 8192), 16, 0, 0); \
        _Pragma("unroll") for (int _i = 0; _i < 2; ++_i) __builtin_amdgcn_global_load_lds((const unsigned*)(_vp + voff[_i]), (LAS unsigned*)(lds + (b) * ATT_STAGE + ATT_KB + ldsw + _i * 8192), 16, 0, 0); } while (0)

    if (wid >= 4) __builtin_amdgcn_s_setprio(1);
    for (int it = bid_l; it < 256; it += gdim_l) {
        const int head = it & 7, pi = it >> 3;
        for (int half = 0; half < 2; ++half) {
            const int qb = half == 0 ? 63 - pi : pi;
            const int q0 = qb * 256, qw0 = q0 + 32 * wid, q = qw0 + r, nt = 4 * qb + 4;
            const char* kbase = (const char*)Kf + head * 192 * 2; const char* vbase = (const char*)Vt + (size_t)head * 128 * SEQ * 2;
            bf16x8 qf[12];
#pragma unroll
            for (int ks = 0; ks < 12; ++ks) qf[ks] = *(const bf16x8*)(Q + (size_t)q * NQ + head * 192 + ks * 16 + h * 8);
            float zf = 0.f; asm volatile("" : "+v"(zf));
            f32x16 o[4];
#pragma unroll
            for (int b = 0; b < 4; ++b)
#pragma unroll
                for (int j = 0; j < 16; ++j) o[b][j] = zf;
            float mrun = -1e30f, lsum = 0.f;
            asm volatile("" ::: "memory"); __builtin_amdgcn_s_barrier(); asm volatile("" ::: "memory");
            ATT_ISSUE(0, 0);
            for (int t = 0; t < nt; ++t) {
                const int b = t & 1;
                asm volatile("s_waitcnt vmcnt(0)" ::: "memory"); __builtin_amdgcn_s_barrier(); asm volatile("" ::: "memory");
                if (t + 1 < nt) ATT_ISSUE(t + 1, b ^ 1);
                if (64 * t <= qw0 + 31) {
                    LAS unsigned char* kb_ = lds + b * ATT_STAGE; LAS unsigned char* vb_ = kb_ + ATT_KB;
                    f32x16 s[2];
#pragma unroll
                    for (int kb = 0; kb < 2; ++kb)
#pragma unroll
                        for (int j = 0; j < 16; ++j) s[kb][j] = zf;
                    unsigned kad[4];
#pragma unroll
                    for (int kl = 0; kl < 4; ++kl) kad[kl] = (unsigned)(size_t)kb_ + (unsigned)koffl[kl];
                    bf16x8 fr_[4];
#define ATT_KRD(i) DSR(fr_[(i) & 3], kad[((i) >> 1) & 3], ((i) & 1) * (32 * 384) + ((i) >> 3) * 128)
                    ATT_KRD(0); ATT_KRD(1); ATT_KRD(2); ATT_KRD(3);
#pragma unroll
                    for (int i = 0; i < 24; ++i) {
                        LGK(i < 21 ? 3 : 23 - i, fr_[i & 3]);
                        s[i & 1] = __builtin_amdgcn_mfma_f32_32x32x16_bf16(fr_[i & 3], qf[i >> 1], s[i & 1], 0, 0, 0);
                        if (i + 4 < 24) ATT_KRD(i + 4);
                    }
#undef ATT_KRD
                    unsigned vad[4];
#pragma unroll
                    for (int c = 0; c < 4; ++c) vad[c] = (unsigned)(size_t)vb_ + (unsigned)voffl[c];
#define ATT_VRD(j) DSR(fr_[(j) & 3], vad[(j) >> 2], ((j) & 3) * 4096)
                    ATT_VRD(0); ATT_VRD(1); ATT_VRD(2); ATT_VRD(3);
                    if (64 * t + 63 > qw0) {
#pragma unroll
                        for (int kb = 0; kb < 2; ++kb)
#pragma unroll
                            for (int j = 0; j < 16; ++j) { const int key = 64 * t + 32 * kb + 16 * (j >> 3) + 8 * h + (j & 7); if (key > q) s[kb][j] = -1e30f; }
                    }
                    float mx = -1e30f;
#pragma unroll
                    for (int kb = 0; kb < 2; ++kb)
#pragma unroll
                        for (int j = 0; j < 16; ++j) mx = fmaxf(mx, s[kb][j]);
                    mx = fmaxf(mx, __shfl_xor(mx, 32));
                    if (__builtin_amdgcn_ballot_w64(mx > mrun + 8.0f) != 0ull) {
                        const float mnew = fmaxf(mrun, mx), alpha = fast_exp2(mrun - mnew); mrun = mnew;
                        lsum *= alpha;
#pragma unroll
                        for (int bb = 0; bb < 4; ++bb)
#pragma unroll
                            for (int j = 0; j < 16; ++j) o[bb][j] *= alpha;
                    }
                    float ps = 0.f;
#pragma unroll
                    for (int kb = 0; kb < 2; ++kb)
#pragma unroll
                        for (int j = 0; j < 16; ++j) { s[kb][j] = fast_exp2(s[kb][j] - mrun); ps += s[kb][j]; }
                    lsum += ps;
#pragma unroll
                    for (int c = 0; c < 4; ++c) {
                        const int kb = c >> 1, sx = c & 1;
                        u32x4 pw;
#pragma unroll
                        for (int j = 0; j < 4; ++j) pw[j] = cvt_pk_bf16(s[kb][8 * sx + 2 * j], s[kb][8 * sx + 2 * j + 1]);
                        const bf16x8 pf = __builtin_bit_cast(bf16x8, pw);
#pragma unroll
                        for (int bb = 0; bb < 4; ++bb) {
                            const int j = c * 4 + bb;
                            LGK(j < 13 ? 3 : 15 - j, fr_[j & 3]);
                            o[bb] = __builtin_amdgcn_mfma_f32_32x32x16_bf16(fr_[j & 3], pf, o[bb], 0, 0, 0);
                            if (j + 4 < 16) ATT_VRD(j + 4);
                        }
                    }
#undef ATT_VRD
                }
            }
            const float ltot = lsum + __shfl_xor(lsum, 32), inv = 1.0f / ltot;
            const int l2 = lane_id_asm(), h2 = l2 >> 5, q2 = qb * 256 + 32 * wid + (l2 & 31);
            u32x2 gwv[16];
#pragma unroll
            for (int e = 0; e < 16; ++e) gwv[e] = *(const u32x2*)(proj + (size_t)q2 * NIN + C_GM + head * 128 + 32 * (e >> 2) + 8 * (e & 3) + 4 * h2);
            __builtin_amdgcn_sched_barrier(0);
#pragma unroll
            for (int bb = 0; bb < 4; ++bb)
#pragma unroll
                for (int jp = 0; jp < 2; ++jp) {
                    u32x2 wv2[2];
#pragma unroll
                    for (int e = 0; e < 2; ++e) { const int gq = 2 * jp + e; const u32x2 gw = gwv[bb * 4 + gq];
                        wv2[e][0] = cvt_pk_bf16(o[bb][4 * gq] * inv * siluf_(bflo(gw[0])), o[bb][4 * gq + 1] * inv * siluf_(bfhi(gw[0])));
                        wv2[e][1] = cvt_pk_bf16(o[bb][4 * gq + 2] * inv * siluf_(bflo(gw[1])), o[bb][4 * gq + 3] * inv * siluf_(bfhi(gw[1]))); }
                    const auto r0 = __builtin_amdgcn_permlane32_swap(wv2[0][0], wv2[1][0], false, false);
                    const auto r1 = __builtin_amdgcn_permlane32_swap(wv2[0][1], wv2[1][1], false, false);
                    u32x4 ov; ov[0] = r0[0]; ov[1] = r1[0]; ov[2] = r0[1]; ov[3] = r1[1];
                    *(u32x4*)(mixed + (size_t)q2 * DM + head * 128 + 32 * bb + 16 * jp + 8 * h2) = ov;
                    __builtin_amdgcn_sched_barrier(0);
                }
        }
    }
    __builtin_amdgcn_s_setprio(0);
    asm volatile("s_waitcnt vmcnt(0)" ::: "memory"); __builtin_amdgcn_s_barrier(); asm volatile("" ::: "memory");
#undef ATT_ISSUE
}

#define XB_TMO      128
#define XB_XCNT(j)  (256  + 64 * (j))
#define XB_XSUB(j)  (1280 + 64 * (j))
#define XB_XGEN(j)  (2304 + 64 * (j))
#define XB_TOP      3328
#define XB_TOPGEN   3392
#define XB_SPIN_CAP (1u << 20)
__device__ __forceinline__ unsigned xb_ld(unsigned* p)              { return __hip_atomic_load(p, __ATOMIC_RELAXED, __HIP_MEMORY_SCOPE_AGENT); }
__device__ __forceinline__ unsigned xb_add(unsigned* p, unsigned v) { return __hip_atomic_fetch_add(p, v, __ATOMIC_RELAXED, __HIP_MEMORY_SCOPE_AGENT); }
__device__ __forceinline__ unsigned xb_xcc_id() { return (unsigned)__builtin_amdgcn_s_getreg((3 << 11) | 20) & 0xFu; }
#define XB_SPIN(cond, bar) do { unsigned _sp = 0; while (cond) { __builtin_amdgcn_s_sleep(1); \
    if ((++_sp & 255u) == 0u) { if (xb_ld(&(bar)[XB_TMO])) break; if (_sp > XB_SPIN_CAP) { atomicAdd(&(bar)[XB_TMO], 1u); break; } } } } while (0)
__device__ __forceinline__ void xcd_barrier_complete(unsigned* bar, unsigned x, unsigned G, unsigned& nloc, unsigned& nx) {
    unsigned sum, cnt, mine, sp = 0u;
    for (;;) {
        sum = 0u; cnt = 0u; mine = 0u;
#pragma unroll
        for (unsigned j = 0; j < 16; ++j) { const unsigned c = xb_ld(&bar[XB_XCNT(j)]); sum += c; cnt += (c > 0u) ? 1u : 0u; mine = (j == x) ? c : mine; }
        if (sum == G) break;
        __builtin_amdgcn_s_sleep(1);
        if ((++sp & 255u) == 0u) { if (xb_ld(&bar[XB_TMO])) break; if (sp > XB_SPIN_CAP) { atomicAdd(&bar[XB_TMO], 1u); break; } }
    }
    nloc = mine > 0u ? mine : 1u; nx = cnt > 0u ? cnt : 1u;
}
__device__ __forceinline__ void xcd_barrier(unsigned* bar, volatile LAS unsigned* st, bool is_t0, unsigned G) {
    asm volatile("s_waitcnt vmcnt(0)" ::: "memory");
    __syncthreads();
    if (is_t0) {
        const unsigned x = xb_xcc_id();
        __builtin_amdgcn_s_waitcnt(0);
        unsigned nloc = st[0], nx = st[1];
        if (nloc == 0u) { xcd_barrier_complete(bar, x, G, nloc, nx); st[0] = nloc; st[1] = nx; }
        const unsigned old = xb_add(&bar[XB_XSUB(x)], 1u);
        const unsigned gen = old / nloc;
        if (old + 1u == (gen + 1u) * nloc) {
            __builtin_amdgcn_fence(__ATOMIC_RELEASE, "agent");
            asm volatile("s_waitcnt vmcnt(0)" ::: "memory");
            const unsigned og = xb_add(&bar[XB_TOP], 1u);
            const unsigned tg = og / nx;
            if (og + 1u == (tg + 1u) * nx) xb_add(&bar[XB_TOPGEN], 1u);
            else XB_SPIN(xb_ld(&bar[XB_TOPGEN]) == tg, bar);
            __builtin_amdgcn_fence(__ATOMIC_ACQUIRE, "agent");
            xb_add(&bar[XB_XGEN(x)], 1u);
            asm volatile("s_waitcnt vmcnt(0)" ::: "memory");
        } else {
            XB_SPIN(xb_ld(&bar[XB_XGEN(x)]) == gen, bar);
            __builtin_amdgcn_fence(__ATOMIC_ACQUIRE, "agent");
            asm volatile("s_waitcnt vmcnt(0)" ::: "memory");
        }
    }
    __syncthreads();
}

constexpr int NPHASE = 1 + 7 * DEPTH;
__device__ __forceinline__ unsigned char* launder_p(unsigned char* x) { asm volatile("" : "+s"(x)); return x; }
#define WSP(T, off) ((T*)(p.ws + (off)))
#define PHASE_FN __device__ __forceinline__
PHASE_FN void ph_init(int wv, const Params& p, LAS unsigned char* lds) { LIDS
    const int G = gdim_l, c = bid_l;
    float* cosT = WSP(float, OFF_COS); float* sinT = WSP(float, OFF_SIN);
    for (int i = c * 512 + tid_l; i < SEQ * 32; i += G * 512) { const int l = i >> 5, k = i & 31; const float ang = (float)p.pos[l] * p.inv_freq[k]; float s, cc; sincos_rev(ang, s, cc); cosT[i] = cc; sinT[i] = s; }
    for (int step = 0; step < 2; ++step) {
        if (((step ^ c) & 1) == 0) { rowpass(wv, p.x, nullptr, nullptr, p.norm_pre, p.out, WSP(bf16_t, OFF_XN), 0); prep_layer(wv, p, 0, lds); }
        else prep_s5_all(wv, p, lds);
    }
}
PHASE_FN void ph_proj(int wv, const Params& p, int layer, LAS unsigned char* lds) { LIDS
    Gemm g{WSP(bf16_t, OFF_XN), WSP(bf16_t, OFF_WIN), DM, DM, DM, (size_t)BM * DM * 2, (size_t)BM * DM * 2, 0};
    StaticOrder S; S.init(SEQ, NIN, gdim_l, bid_l); EpiProj E{WSP(bf16_t, OFF_PROJ), WSP(bf16_t, OFF_UCAT), WSP(float, OFF_SS)};
    gemm_phase(wv, lds, g, S, E);
}
PHASE_FN void ph_q(int wv, const Params& p, int layer, LAS unsigned char* lds) { LIDS
    Gemm g{WSP(bf16_t, OFF_PROJ) + C_CQ, WSP(bf16_t, OFF_WUQ), NIN, 512, 512, (size_t)BM * NIN * 2, (size_t)BM * 512 * 2, 0};
    StaticOrder S; S.init(SEQ, NQ, gdim_l, bid_l); EpiQ E{WSP(bf16_t, OFF_Q), WSP(float, OFF_SS), WSP(float, OFF_COS), WSP(float, OFF_SIN)}; gemm_phase(wv, lds, g, S, E);
}
PHASE_FN void ph_k(int wv, const Params& p, int layer, LAS unsigned char* lds) { LIDS
    const int G = gdim_l;
    Gemm g{WSP(bf16_t, OFF_PROJ) + C_CKV, WSP(bf16_t, OFF_WK), NIN, 256, 256, (size_t)BM * NIN * 2, (size_t)BM * 256 * 2, 0};
    StaticOrder S; S.init(SEQ, 1024, G, (bid_l + G / 2) % G); EpiK E{WSP(bf16_t, OFF_KF), WSP(float, OFF_SS)}; gemm_phase(wv, lds, g, S, E);
}
PHASE_FN void ph_v(int wv, const Params& p, int layer, LAS unsigned char* lds) { LIDS
    Gemm g{WSP(bf16_t, OFF_WV), WSP(bf16_t, OFF_PROJ) + C_CKV, 256, NIN, 256, (size_t)BM * 256 * 2, (size_t)BM * NIN * 2, 0};
    StaticOrder S; S.init(1024, SEQ, gdim_l, bid_l); EpiVt E{WSP(bf16_t, OFF_VT), WSP(float, OFF_SS)}; gemm_phase(wv, lds, g, S, E);
}
PHASE_FN void ph_e(int wv, const Params& p, int layer, LAS unsigned char* lds) { LIDS
    const int G = gdim_l;
    Gemm g{WSP(bf16_t, OFF_UCAT), WSP(bf16_t, OFF_BT1 + layer * BT1_BYTES), KCAT, 256, 256, (size_t)BM * KCAT * 2, (size_t)128 * 256 * 2, 0};
    GroupOrderE S{G, bid_l}; EpiE E{WSP(float, OFF_EBUF)}; gemm_phase(wv, lds, g, S, E);
    krope_pass(wv, WSP(bf16_t, OFF_PROJ), WSP(float, OFF_COS), WSP(float, OFF_SIN), WSP(bf16_t, OFF_KF));
}
PHASE_FN void ph_scan(int wv, const Params& p, int layer, LAS unsigned char* lds) { s5_scan(wv, p, layer, WSP(float, OFF_EBUF), WSP(bf16_t, OFF_UCAT), lds); }
PHASE_FN void ph_attn(int wv, const Params& p, int layer, LAS unsigned char* lds) {
    attn_phase(wv, WSP(bf16_t, OFF_Q), WSP(bf16_t, OFF_KF), WSP(bf16_t, OFF_VT), WSP(bf16_t, OFF_PROJ), WSP(bf16_t, OFF_MIXED), lds);
}
PHASE_FN void ph_y(int wv, const Params& p, int layer, LAS unsigned char* lds) { LIDS
    Gemm g{WSP(bf16_t, OFF_UCAT), WSP(bf16_t, OFF_BT2 + layer * BT2_BYTES), KCAT, KCAT, KCAT, (size_t)BM * KCAT * 2, (size_t)BM * KCAT * 2, 0};
    GroupOrder S{gdim_l, bid_l}; EpiY E{WSP(bf16_t, OFF_YACT), WSP(bf16_t, OFF_UCAT), p.d_skip + (size_t)layer * 1024}; gemm_phase(wv, lds, g, S, E);
}
PHASE_FN void ph_glu(int wv, const Params& p, int layer, LAS unsigned char* lds) { LIDS
    Gemm g{WSP(bf16_t, OFF_YACT), WSP(bf16_t, OFF_WGLU), 1024, 1024, 1024, (size_t)BM * 32, (size_t)BM * 1024 * 2, 1};
    StaticOrder S; S.init(SEQ, 2048, gdim_l, bid_l); EpiGlu E{WSP(bf16_t, OFF_MIXED), WSP(bf16_t, OFF_PROJ)}; gemm_phase(wv, lds, g, S, E);
}
PHASE_FN void ph_out(int wv, const Params& p, int layer, LAS unsigned char* lds) { LIDS
    Gemm g{WSP(bf16_t, OFF_MIXED), WSP(bf16_t, OFF_WOUT), DM, DM, DM, (size_t)BM * DM * 2, (size_t)BM * DM * 2, 0};
    StaticOrder S; S.init(SEQ, DM, gdim_l, bid_l); EpiOut E{WSP(bf16_t, OFF_OUTB)}; gemm_phase(wv, lds, g, S, E);
}
PHASE_FN void ph_row(int wv, const Params& p, int layer, LAS unsigned char* lds) { LIDS
    rowpass(wv, layer == 0 ? p.x : p.out, WSP(bf16_t, OFF_OUTB), p.norm_post + (size_t)layer * DM, layer + 1 < DEPTH ? p.norm_pre + (size_t)(layer + 1) * DM : nullptr, p.out, WSP(bf16_t, OFF_XN), 1);
    if (layer + 1 < DEPTH) prep_layer(wv, p, layer + 1, lds);
}
__global__ void __launch_bounds__(512) hymba_megakernel(Params p) {
    extern __shared__ __attribute__((aligned(16))) unsigned char shm_raw[];
    LAS unsigned char* lds = (LAS unsigned char*)shm_raw;
    const int wv = __builtin_amdgcn_readfirstlane((int)(threadIdx.x >> 6));
    __shared__ uint4 xb_words;
    unsigned* bar = (unsigned*)(p.ws + OFF_BAR);
    if (p.coop) {
        if (threadIdx.x == 0) { xb_words = make_uint4(0u, 0u, 0u, 0u); (void)xb_add(&bar[XB_XCNT(xb_xcc_id())], 1u); }
        __syncthreads();
    }
    for (int ph = p.ph_begin; ph < p.ph_end; ++ph) {
        if (ph == 0) ph_init(wv, p, lds);
        else {
            const int layer = (ph - 1) / 7, sub = (ph - 1) % 7;
            if (sub == 0) ph_proj(wv, p, layer, lds);
            else if (sub == 1) { ph_q(wv, p, layer, lds); ph_k(wv, p, layer, lds); ph_v(wv, p, layer, lds); ph_e(wv, p, layer, lds); }
            else if (sub == 2) { ph_scan(wv, p, layer, lds); ph_attn(wv, p, layer, lds); }
            else if (sub == 3) ph_y(wv, p, layer, lds);
            else if (sub == 4) ph_glu(wv, p, layer, lds);
            else if (sub == 5) ph_out(wv, p, layer, lds);
            else ph_row(wv, p, layer, lds);
        }
        if (ph + 1 < p.ph_end && p.coop) {
            if (p.coop > 1) cg::this_grid().sync();
            else xcd_barrier(bar, (volatile LAS unsigned*)&xb_words, lane_id_asm() == 0 && wv == 0, gridDim.x);
        }
    }
}

extern "C" void kernel_launch(void* const* d_in, const int* in_sizes, int n_in, void* d_out, int out_size, void* d_ws, size_t ws_size, hipStream_t stream) {
    constexpr size_t kDynLds = STAGE_BYTES;
    static int grid_blocks = 0;
    if (!grid_blocks) {
        hipFuncSetAttribute((const void*)hymba_megakernel, hipFuncAttributeMaxDynamicSharedMemorySize, (int)kDynLds);
        int dev = 0, cus = 0, per_cu = 0;
        hipGetDevice(&dev);
        hipDeviceGetAttribute(&cus, hipDeviceAttributeMultiprocessorCount, dev);
        hipOccupancyMaxActiveBlocksPerMultiprocessor(&per_cu, hymba_megakernel, 512, kDynLds);
        if (per_cu < 1) per_cu = 1;
        grid_blocks = cus * per_cu; if (grid_blocks > 256) grid_blocks = 256;
    }
    if (ws_size < WS_NEED) { fprintf(stderr, "workspace too small: %zu < %zu\n", ws_size, (size_t)WS_NEED); }
    Params p; memset(&p, 0, sizeof(p));
    p.x = (const float*)d_in[0]; p.pos = (const int*)d_in[1]; p.norm_pre = (const float*)d_in[2]; p.norm_post = (const float*)d_in[3]; p.w_in = (const float*)d_in[4];
    p.q_norm = (const float*)d_in[5]; p.w_uq = (const float*)d_in[6]; p.kv_norm = (const float*)d_in[7]; p.w_ukv = (const float*)d_in[8];
    p.a_re = (const float*)d_in[9]; p.a_im = (const float*)d_in[10]; p.b_re = (const float*)d_in[11]; p.b_im = (const float*)d_in[12]; p.c_re = (const float*)d_in[13]; p.c_im = (const float*)d_in[14];
    p.d_skip = (const float*)d_in[15]; p.log_step = (const float*)d_in[16]; p.w_glu = (const float*)d_in[17]; p.w_out = (const float*)d_in[18];
    p.out = (float*)d_out; p.ws = (unsigned char*)d_ws;
    for (int i = 0; i < 32; ++i) p.inv_freq[i] = (float)std::pow(10000.0, -(double)i / 32.0);
#ifdef MULTI_LAUNCH
    for (int ph = 0; ph < NPHASE; ++ph) { p.ph_begin = ph; p.ph_end = ph + 1; p.coop = 0; hipLaunchKernelGGL(hymba_megakernel, dim3(grid_blocks), dim3(512), kDynLds, stream, p); }
#else
    p.ph_begin = 0; p.ph_end = NPHASE; p.coop = 1;
    (void)hipMemsetAsync((unsigned char*)d_ws + OFF_BAR, 0, BAR_BYTES, stream);
    void* args[] = {&p};
    hipError_t e = hipLaunchCooperativeKernel((void*)hymba_megakernel, dim3(grid_blocks), dim3(512), args, kDynLds, stream);
    if (e != hipSuccess) fprintf(stderr, "cooperative launch failed: %s (grid %d)\n", hipGetErrorString(e), grid_blocks);
#endif
}
```
